# Optimizing an MI355X kernel written in HIP

```python
import math
import jax
import jax.numpy as jnp
from jax import lax
import numpy as np

D_MODEL = 2048
BATCH = 2
SEQ = 4096
DEPTH = 2

GRID_W = 64
CTX_LEN = 256
HEAD_DIM = 128
NA_W = D_MODEL // 2
NA_HEADS = NA_W // HEAD_DIM
WIN_H_MAX = 8
WIN_W = 16
LRU_W = D_MODEL // 4
LRU_BLOCKS = 4
LRU_BW = LRU_W // LRU_BLOCKS
CONV_W = 4
LRU_C = 8.0
FNET_W = D_MODEL // 4
FNET_GROUPS = 4
FNET_GW = FNET_W // FNET_GROUPS
MIX_W = NA_W + LRU_W + FNET_W
Q0 = 0
K0 = NA_W
V0 = 2 * NA_W
X0 = 3 * NA_W
G0 = X0 + LRU_W
F0 = G0 + LRU_W
IN_W = F0 + FNET_W
D_FF = 4 * D_MODEL
ROPE_THETA = 10000.0
LN_EPS = 1e-5
NEG_INF = -1e30

kernel_name = "hybrid_na_rglru_fnet_deepnorm_dit"


def layer_norm(x, g=None, b=None):
    xf = x.astype(jnp.float32)
    mu = jnp.mean(xf, -1, keepdims=True)
    var = jnp.mean(jnp.square(xf - mu), -1, keepdims=True)
    y = (xf - mu) * lax.rsqrt(var + LN_EPS)
    if g is not None:
        y = y * g.astype(jnp.float32) + b.astype(jnp.float32)
    return y.astype(x.dtype)


def axial_rope(x, rows, cols):
    half = HEAD_DIM // 2
    quarter = half // 2
    inv = ROPE_THETA ** (-jnp.arange(quarter, dtype=jnp.float32) / quarter)

    def rot(xa, pos):
        ang = pos.astype(jnp.float32)[:, None] * inv
        cos = jnp.cos(ang)[None, :, None, :]
        sin = jnp.sin(ang)[None, :, None, :]
        x1, x2 = xa[..., :quarter], xa[..., quarter:]
        return jnp.concatenate([x1 * cos - x2 * sin, x1 * sin + x2 * cos], -1)

    xf = x.astype(jnp.float32)
    out = jnp.concatenate([rot(xf[..., :half], rows), rot(xf[..., half:], cols)], -1)
    return out.astype(x.dtype)


def neighbourhood_attention(q, k, v, kc, vc, rpb):
    B, L, H, d = q.shape
    rows = L // GRID_W
    kh = min(WIN_H_MAX, rows)
    scale = d ** -0.5
    t = jnp.arange(L)
    qr = axial_rope(q, t // GRID_W, t % GRID_W)
    kr = axial_rope(k, t // GRID_W, t % GRID_W)
    grid = lambda a: a.reshape(B, rows, GRID_W, H, d)
    qg, qrg, krg, vg = grid(q), grid(qr), grid(kr), grid(v)
    r = jnp.arange(rows)
    row_start = jnp.clip(r - kh // 2, 0, rows - kh)
    row_idx = row_start[:, None] + jnp.arange(kh)
    k_band = krg[:, row_idx]
    v_band = vg[:, row_idx]
    s_band = jnp.einsum('brqhd,brkchd->bhrqkc', qrg, k_band).astype(jnp.float32) * scale
    col = jnp.arange(GRID_W)
    col_start = jnp.clip(col - WIN_W // 2, 0, GRID_W - WIN_W)
    in_win = (col[None, :] >= col_start[:, None]) & (col[None, :] < col_start[:, None] + WIN_W)
    dr = row_idx - r[:, None] + (WIN_H_MAX - 1)
    dc = jnp.clip(col[None, :] - col[:, None] + (WIN_W - 1), 0, 2 * WIN_W - 2)
    bias = rpb[:, dr[:, None, :, None], dc[None, :, None, :]].astype(jnp.float32)
    s_band = jnp.where(in_win[:, None, :], s_band + bias[None], NEG_INF)
    s_ctx = jnp.einsum('brqhd,bchd->bhrqc', qg, kc).astype(jnp.float32) * scale
    n_band = kh * GRID_W
    s = jnp.concatenate([s_band.reshape(B, H, rows, GRID_W, n_band), s_ctx], -1)
    p = jax.nn.softmax(s, axis=-1).astype(v.dtype)
    p_band = p[..., :n_band].reshape(B, H, rows, GRID_W, kh, GRID_W)
    p_ctx = p[..., n_band:]
    out = (jnp.einsum('bhrqkc,brkchd->brqhd', p_band, v_band)
           + jnp.einsum('bhrqc,bchd->brqhd', p_ctx, vc))
    return out.reshape(B, L, H * d)


def context_attention(qc, kc, vc):
    B, C, H, d = qc.shape
    s = jnp.einsum('bqhd,bkhd->bhqk', qc, kc).astype(jnp.float32) * (d ** -0.5)
    p = jax.nn.softmax(s, axis=-1).astype(vc.dtype)
    return jnp.einsum('bhqk,bkhd->bqhd', p, vc).reshape(B, C, H * d)


def centred_conv(x, w, b):
    L = x.shape[1]
    left = CONV_W // 2
    xp = jnp.pad(x, ((0, 0), (left, CONV_W - 1 - left), (0, 0)))
    out = xp[:, 0:L] * w[0]
    for j in range(1, CONV_W):
        out = out + xp[:, j:j + L] * w[j]
    return out + b


def block_diag(x, w, b):
    xb = x.reshape(*x.shape[:-1], LRU_BLOCKS, LRU_BW)
    return jnp.einsum('blnc,ncd->blnd', xb, w).reshape(x.shape) + b


def rglru_coeffs(x, wa, ba, wx, bx, lam):
    xf = x.astype(jnp.float32)
    r = jax.nn.sigmoid(block_diag(xf, wa, ba).astype(jnp.float32))
    i = jax.nn.sigmoid(block_diag(xf, wx, bx).astype(jnp.float32))
    log_a = -LRU_C * r * jax.nn.softplus(-lam.astype(jnp.float32))
    a = jnp.exp(log_a)
    u = jnp.sqrt(-jnp.expm1(2.0 * log_a)) * (i * xf)
    return a, u


def _scan_combine(e1, e2):
    a1, b1 = e1
    a2, b2 = e2
    return a1 * a2, a2 * b1 + b2


def linear_scan(a, u, h0, reverse):
    if reverse:
        a, u = jnp.flip(a, 1), jnp.flip(u, 1)
    u = u.at[:, 0].add(a[:, 0] * h0)
    _, h = lax.associative_scan(_scan_combine, (a, u), axis=1)
    h_last = h[:, -1]
    if reverse:
        h = jnp.flip(h, 1)
    return h, h_last


def bidirectional_rglru(xl, xc, conv_w, conv_b, wa, ba, wx, bx, lam):
    xl = centred_conv(xl, conv_w, conv_b)
    xc = centred_conv(xc, conv_w, conv_b)
    h0 = jnp.zeros((xc.shape[0], LRU_W), jnp.float32)
    y_lat, y_ctx = None, None
    for d, rev in enumerate((False, True)):
        a_c, u_c = rglru_coeffs(xc, wa[d], ba[d], wx[d], bx[d], lam[d])
        h_c, h_last = linear_scan(a_c, u_c, h0, rev)
        a_l, u_l = rglru_coeffs(xl, wa[d], ba[d], wx[d], bx[d], lam[d])
        h_l, _ = linear_scan(a_l, u_l, h_last, rev)
        y_lat = h_l if y_lat is None else y_lat + h_l
        y_ctx = h_c if y_ctx is None else y_ctx + h_c
    return y_lat.astype(xl.dtype), y_ctx.astype(xc.dtype)


def fourier_mix(x, w, b):
    B, L, _ = x.shape
    xg = x.astype(jnp.float32).reshape(B, L, FNET_GROUPS, FNET_GW)
    y = jnp.real(jnp.fft.fft2(xg, axes=(1, 3), norm='ortho')).reshape(B, L, FNET_W)
    return y.astype(x.dtype) @ w + b


def token_mixers(u_lat, u_ctx, w_in, rpb, conv_w, conv_b, wa, ba, wx, bx, lam, fno_w, fno_b, w_out, ctx_out):
    heads = lambda t: t.reshape(*t.shape[:2], NA_HEADS, HEAD_DIM)
    p_lat = u_lat @ w_in
    q, k, v = heads(p_lat[..., Q0:K0]), heads(p_lat[..., K0:V0]), heads(p_lat[..., V0:X0])
    if ctx_out:
        p_ctx = u_ctx @ w_in
    else:
        p_ctx = u_ctx @ w_in[:, K0:G0]
        p_ctx = jnp.pad(p_ctx, ((0, 0), (0, 0), (K0, IN_W - G0)))[..., :G0] if False else None
    if ctx_out:
        kc, vc, xrc = heads(p_ctx[..., K0:V0]), heads(p_ctx[..., V0:X0]), p_ctx[..., X0:G0]
    else:
        pc = u_ctx @ w_in[:, K0:G0]
        kc, vc, xrc = heads(pc[..., :NA_W]), heads(pc[..., NA_W:2 * NA_W]), pc[..., 2 * NA_W:]
    na_lat = neighbourhood_attention(q, k, v, kc, vc, rpb)
    h_lat, h_ctx = bidirectional_rglru(p_lat[..., X0:G0], xrc, conv_w, conv_b, wa, ba, wx, bx, lam)
    lru_lat = h_lat * jax.nn.gelu(p_lat[..., G0:F0])
    f_lat = fourier_mix(p_lat[..., F0:IN_W], fno_w, fno_b)
    m_lat = jnp.concatenate([na_lat, lru_lat, f_lat], -1) @ w_out
    if not ctx_out:
        return m_lat, None
    na_ctx = context_attention(heads(p_ctx[..., Q0:K0]), kc, vc)
    lru_ctx = h_ctx * jax.nn.gelu(p_ctx[..., G0:F0])
    f_ctx = fourier_mix(p_ctx[..., F0:IN_W], fno_w, fno_b)
    m_ctx = jnp.concatenate([na_ctx, lru_ctx, f_ctx], -1) @ w_out
    return m_lat, m_ctx


def sq_relu_mlp(u, w1, b1, w2, b2):
    return jnp.square(jax.nn.relu(u @ w1 + b1)) @ w2 + b2


def setup_inputs(seed: int = 0) -> dict:
    key = jax.random.key(seed)
    ks = jax.random.split(key, 32)
    f32 = jnp.float32
    nrm = lambda k, shape, s: jax.random.normal(k, shape, f32) * s
    beta = (8.0 * DEPTH) ** -0.25
    u = jax.random.uniform(ks[14], (DEPTH, 2, LRU_W), f32, 0.9, 0.999)
    a0 = u ** (1.0 / LRU_C)
    lam = jnp.log(a0) - jnp.log1p(-a0)
    return {
        "x": nrm(ks[0], (BATCH, SEQ, D_MODEL), 1.0),
        "c": nrm(ks[1], (BATCH, D_MODEL), 1.0),
        "ctx": nrm(ks[2], (BATCH, CTX_LEN, D_MODEL), 1.0),
        "c_ctx": nrm(ks[3], (D_MODEL,), 1.0),
        "w_mod": nrm(ks[4], (DEPTH, D_MODEL, 6 * D_MODEL), 0.5 * D_MODEL ** -0.5),
        "b_mod": nrm(ks[5], (DEPTH, 6 * D_MODEL), 0.02),
        "w_in": nrm(ks[6], (DEPTH, D_MODEL, IN_W), D_MODEL ** -0.5),
        "rpb": nrm(ks[7], (DEPTH, NA_HEADS, 2 * WIN_H_MAX - 1, 2 * WIN_W - 1), 0.1),
        "conv_w": nrm(ks[8], (DEPTH, CONV_W, LRU_W), CONV_W ** -0.5),
        "conv_b": nrm(ks[9], (DEPTH, LRU_W), 0.02),
        "lru_wa": nrm(ks[10], (DEPTH, 2, LRU_BLOCKS, LRU_BW, LRU_BW), LRU_BW ** -0.5),
        "lru_ba": nrm(ks[11], (DEPTH, 2, LRU_W), 0.02),
        "lru_wx": nrm(ks[12], (DEPTH, 2, LRU_BLOCKS, LRU_BW, LRU_BW), LRU_BW ** -0.5),
        "lru_bx": nrm(ks[13], (DEPTH, 2, LRU_W), 0.02),
        "lru_lambda": lam,
        "fno_w": nrm(ks[15], (DEPTH, FNET_W, FNET_W), FNET_W ** -0.5),
        "fno_b": nrm(ks[16], (DEPTH, FNET_W), 0.02),
        "w_out": nrm(ks[17], (DEPTH, MIX_W, D_MODEL), beta * MIX_W ** -0.5),
        "ln1_g": 1.0 + nrm(ks[18], (DEPTH, D_MODEL), 0.02),
        "ln1_b": nrm(ks[19], (DEPTH, D_MODEL), 0.02),
        "w_fc1": nrm(ks[20], (DEPTH, D_MODEL, D_FF), D_MODEL ** -0.5),
        "b_fc1": nrm(ks[21], (DEPTH, D_FF), 0.02),
        "w_fc2": nrm(ks[22], (DEPTH, D_FF, D_MODEL), beta * D_FF ** -0.5),
        "b_fc2": nrm(ks[23], (DEPTH, D_MODEL), 0.02),
        "ln2_g": 1.0 + nrm(ks[24], (DEPTH, D_MODEL), 0.02),
        "ln2_b": nrm(ks[25], (DEPTH, D_MODEL), 0.02),
    }


def reference(x, c, ctx, c_ctx, w_mod, b_mod, w_in, rpb, conv_w, conv_b, lru_wa, lru_ba, lru_wx, lru_bx,
              lru_lambda, fno_w, fno_b, w_out, ln1_g, ln1_b, w_fc1, b_fc1, w_fc2, b_fc2, ln2_g, ln2_b):
    alpha = (2.0 * DEPTH) ** 0.25
    for l in range(DEPTH):
        ctx_out = l < DEPTH - 1
        mod_lat = jax.nn.silu(c) @ w_mod[l] + b_mod[l]
        mod_ctx = jax.nn.silu(c_ctx[None]) @ w_mod[l] + b_mod[l]
        sh1, sc1, g1, sh2, sc2, g2 = jnp.split(mod_lat[:, None], 6, axis=-1)
        csh1, csc1, cg1, csh2, csc2, cg2 = jnp.split(mod_ctx[:, None], 6, axis=-1)
        u_lat = layer_norm(x) * (1.0 + sc1) + sh1
        u_ctx = layer_norm(ctx) * (1.0 + csc1) + csh1
        m_lat, m_ctx = token_mixers(u_lat, u_ctx, w_in[l], rpb[l], conv_w[l], conv_b[l], lru_wa[l], lru_ba[l],
                                    lru_wx[l], lru_bx[l], lru_lambda[l], fno_w[l], fno_b[l], w_out[l], ctx_out)
        x = layer_norm(alpha * x + g1 * m_lat, ln1_g[l], ln1_b[l])
        v_lat = layer_norm(x) * (1.0 + sc2) + sh2
        x = layer_norm(alpha * x + g2 * sq_relu_mlp(v_lat, w_fc1[l], b_fc1[l], w_fc2[l], b_fc2[l]), ln2_g[l], ln2_b[l])
        if ctx_out:
            ctx = layer_norm(alpha * ctx + cg1 * m_ctx, ln1_g[l], ln1_b[l])
            v_ctx = layer_norm(ctx) * (1.0 + csc2) + csh2
            ctx = layer_norm(alpha * ctx + cg2 * sq_relu_mlp(v_ctx, w_fc1[l], b_fc1[l], w_fc2[l], b_fc2[l]),
                             ln2_g[l], ln2_b[l])
    return x
```

```cpp
#include <hip/hip_runtime.h>
#include <hip/hip_cooperative_groups.h>
#include <cstdio>
#include <cstdint>
namespace cg = cooperative_groups;
#ifndef REP_PRO
#define REP_PRO 1
#endif
#ifndef REP_ATT
#define REP_ATT 1
#endif
#ifndef REP_ELT
#define REP_ELT 1
#endif
#ifndef REP_INPROJ
#define REP_INPROJ 1
#endif
#ifndef REP_FC1
#define REP_FC1 1
#endif
#ifndef REP_DFTG
#define REP_DFTG 1
#endif
#ifndef REP_PA
#define REP_PA 1
#endif
#ifndef REP_PB
#define REP_PB 1
#endif
#ifndef REP_PC
#define REP_PC 1
#endif
#ifndef REP_PD
#define REP_PD 1
#endif
#ifndef REP_WOUT
#define REP_WOUT 1
#endif
#ifndef REP_FC2
#define REP_FC2 1
#endif
#ifndef REP_SYNC
#define REP_SYNC 1
#endif
#define GSYNC() do { for (int _r = 0; _r < REP_SYNC; ++_r) { XcdBarrier xb_; xb_.bar = (unsigned*)(p.ws + O_BAR); xb_.x = xb_xcc_id(); xb_.st = (volatile LAS unsigned*)(lds + 131072 + 64); xcd_barrier(xb_); } } while (0)

#define LAS __attribute__((address_space(3)))
typedef unsigned short bf16;
typedef short bf16x8 __attribute__((ext_vector_type(8)));
typedef float f32x4 __attribute__((ext_vector_type(4)));
typedef float f32x2 __attribute__((ext_vector_type(2)));
typedef unsigned u32x4 __attribute__((ext_vector_type(4)));
typedef unsigned u32x2 __attribute__((ext_vector_type(2)));

constexpr int D = 2048, ML = 8192, MT = 8704, DFF = 8192, NP1 = 3072;
constexpr float LN_EPS = 1e-5f;
constexpr float ALPHA = 1.41421356237f;
constexpr int NWAVES = 8, NTHR = 512;
constexpr int LDS_BYTES = 147456;

constexpr size_t O_WIN = 0;
constexpr size_t O_WOUT = O_WIN + 41943040;
constexpr size_t O_W1 = O_WOUT + 16777216;
constexpr size_t O_W2 = O_W1 + 67108864;
constexpr size_t O_WG = O_W2 + 67108864;
constexpr size_t O_WF = O_WG + 4194304;
constexpr size_t O_WFOLD = O_WF + 4194304;
constexpr size_t O_DFT = O_WFOLD + 2097152;
constexpr size_t O_DFTC = O_DFT + 67108864;
constexpr size_t O_MODV = O_DFTC + 262144;
constexpr size_t O_X = O_MODV + 294912;
constexpr size_t O_Y = O_X + 71303168;
constexpr size_t O_U = O_Y + 71303168;
constexpr size_t O_MIX = O_U + 35651584;
constexpr size_t O_R = O_MIX + 35651584;
constexpr size_t O_P1 = O_R;
constexpr size_t O_VT = O_P1 + 53477376;
constexpr size_t O_ABT = O_VT + 17825792;
constexpr size_t O_ABTC = O_ABT + 16777216;
constexpr size_t O_QR = O_ABTC + 1048576;
constexpr size_t O_KR = O_QR + 16777216;
constexpr size_t O_XC = O_KR + 17825792;
constexpr size_t O_AA = O_XC + 8912896;
constexpr size_t O_UU = O_AA + 35651584;
constexpr size_t O_PART = O_UU + 35651584;
constexpr size_t O_SUMA = O_PART + 71303168;
constexpr size_t O_SUMB = O_SUMA + 557056;
constexpr size_t O_SPT = O_SUMB + 557056;
constexpr size_t O_CPART = O_SPT + 8192;
constexpr size_t O_BAR = O_CPART + 33554432;
constexpr size_t O_CNT = O_BAR + 16384;
constexpr size_t O_XB = O_CNT + 131072;
constexpr size_t O_END = O_XB + 2 * 524288;
constexpr size_t MEMSET_BYTES = 16384 + 131072;
constexpr size_t O_H = O_R;
static_assert(O_H + 142606336 <= O_END, "H overlay");

struct Params { const float* in[26]; float* out; unsigned char* ws; };
enum { I_X = 0, I_C, I_CTX, I_CCTX, I_WMOD, I_BMOD, I_WIN, I_RPB, I_CONVW, I_CONVB, I_WA, I_BA, I_WX, I_BX, I_LAM, I_FNOW, I_FNOB, I_WOUT, I_LN1G, I_LN1B, I_WFC1, I_BFC1, I_WFC2, I_BFC2, I_LN2G, I_LN2B };

__device__ __forceinline__ int lane_id_fresh() { unsigned m = ~0u; asm volatile("" : "+s"(m)); return (int)__builtin_amdgcn_mbcnt_hi(m, __builtin_amdgcn_mbcnt_lo(m, 0u)); }
__device__ __forceinline__ unsigned pk2(float lo, float hi) { unsigned r; asm volatile("v_cvt_pk_bf16_f32 %0, %1, %2" : "=v"(r) : "v"(lo), "v"(hi)); return r; }
__device__ __forceinline__ float bf2f(unsigned h) { return __uint_as_float(h << 16); }
__device__ __forceinline__ float sigmoidf_(float x) { return 1.0f / (1.0f + __expf(-x)); }
__device__ __forceinline__ float sigmoid_fast(float x) { return __builtin_amdgcn_rcpf(1.0f + __builtin_amdgcn_exp2f(-1.4426950408889634f * x)); }

namespace pg8 {
constexpr int BM = 256, BK = 64, HALF = 128, HTB = HALF * BK * 2, NXCD = 8, WGM = 8;
__device__ __forceinline__ int lds_byte(int r, int c) { const int st = (r >> 4) * 2 + (c >> 5), rr = r & 15, cc = c & 31, ob = rr * 64 + cc * 2; return st * 1024 + (ob ^ (((ob >> 9) & 1) << 5)); }
__device__ __forceinline__ void stage_rc(int b, int& R, int& C) { const int st = b / 1024, sb = b % 1024, swz = sb ^ (((sb >> 9) & 1) << 5); R = (st >> 1) * 16 + swz / 64; C = (st & 1) * 32 + (swz % 64) / 2; }
__device__ __forceinline__ int perm32(int rho) { const int n = rho >> 4, i = rho & 15; return 8 * (i >> 2) + 4 * n + (i & 3); }

struct Unit { const char* a; const char* b; int pm, pn, aux; };

__device__ __forceinline__ void tile_of(int L, int nM, int nN, int& pm, int& pn) {
    const int nwg = nM * nN; int wgid = L;
    { const int q = nwg / NXCD, r = nwg % NXCD, xcd = wgid % NXCD, off = wgid / NXCD; wgid = (xcd < r ? xcd * (q + 1) : r * (q + 1) + (xcd - r) * q) + off; }
    const int nig = WGM * nN, gid = wgid / nig, fm = gid * WGM, gsz = (nM - fm) < WGM ? (nM - fm) : WGM;
    pm = fm + ((wgid % nig) % gsz); pn = (wgid % nig) / gsz;
}

template <class Epi, class Sched>
__device__ __forceinline__ void gemm_phase(LAS unsigned char* lds, const int wave_, const int lda_, const int ldb_, const int nt_, const Sched& S, const Epi& E) {
    int lda = lda_, ldb = ldb_, nt = nt_; asm volatile("" : "+s"(lda), "+s"(ldb), "+s"(nt));
    int lane = lane_id_fresh(); int wid = wave_; asm volatile("" : "+v"(lane), "+s"(wid));
    const int tid = wid * 64 + lane, wr = wid >> 2, wc = wid & 3, fr = lane & 15, fq = lane >> 4;
    unsigned voffA[2], voffB[2];
#pragma unroll
    for (int i = 0; i < 2; ++i) { int R, C; stage_rc(tid * 16 + i * 8192, R, C); const int Rb = Epi::PERM ? ((R & ~31) + perm32(R & 31)) : R;
        voffA[i] = (unsigned)(R * lda + C) * 2u; voffB[i] = (unsigned)(Rb * ldb + C) * 2u; }
    const size_t kstep = (size_t)(BK * 2);
    const size_t hstepA = (size_t)HALF * lda * 2, hstepB = (size_t)HALF * ldb * 2;
    const unsigned ldsw = (unsigned)wid * 1024u;
    const int aoff = lds_byte(wr * 64 + fr, fq * 8), boff = lds_byte(wc * 32 + fr, fq * 8);
#define PG8_SA(b, h) (((b) * 2 + (h)) * HTB)
#define PG8_SB(b, h) ((4 + (b) * 2 + (h)) * HTB)
#define PG8_STAGE(bufoff, gbase, voff) do { _Pragma("unroll") for (int _i = 0; _i < 2; ++_i) \
        __builtin_amdgcn_global_load_lds((const unsigned*)((const char*)(gbase) + (voff)[_i]), (LAS unsigned*)(lds + (bufoff) + ldsw + _i * 8192), 16, 0, 0); } while (0)
#define PG8_LDA(dst, b, h) do { _Pragma("unroll") for (int m = 0; m < 4; ++m) _Pragma("unroll") for (int k = 0; k < 2; ++k) dst[m][k] = *(const LAS bf16x8*)(lds + PG8_SA(b, h) + aoff + m * 2048 + k * 1024); } while (0)
#define PG8_LDB(dst, b, h) do { _Pragma("unroll") for (int n = 0; n < 2; ++n) _Pragma("unroll") for (int k = 0; k < 2; ++k) dst[n][k] = *(const LAS bf16x8*)(lds + PG8_SB(b, h) + boff + n * 2048 + k * 1024); } while (0)
#define PG8_MMA(ai, bj, At, Bt) do { __builtin_amdgcn_s_setprio(1); _Pragma("unroll") for (int m = 0; m < 4; ++m) _Pragma("unroll") for (int n = 0; n < 2; ++n) _Pragma("unroll") for (int k = 0; k < 2; ++k) \
        acc[ai][bj][m][n] = __builtin_amdgcn_mfma_f32_16x16x32_bf16(Bt[n][k], At[m][k], acc[ai][bj][m][n], 0, 0, 0); __builtin_amdgcn_s_setprio(0); } while (0)
#define PG8_WAIT_V(n) asm volatile("s_waitcnt vmcnt(" #n ")" ::: "memory")
#define PG8_WAIT_L(n) asm volatile("s_waitcnt lgkmcnt(" #n ")" ::: "memory")
#define PG8_BAR __builtin_amdgcn_s_barrier()
#define PG8_SCHED __builtin_amdgcn_sched_barrier(0)
    Unit cur, nxt; int ui = 0;
    if (!S.next(0, cur)) return;
    f32x4 acc[2][2][4][2];
#pragma unroll
    for (int a = 0; a < 2; ++a)
#pragma unroll
        for (int b = 0; b < 2; ++b)
#pragma unroll
            for (int m = 0; m < 4; ++m)
#pragma unroll
                for (int n = 0; n < 2; ++n) acc[a][b][m][n] = (f32x4){0.f, 0.f, 0.f, 0.f};
    bf16x8 At[4][2], B0[2][2], B1[2][2];
    const char* cA = cur.a; const char* cB = cur.b;
    PG8_STAGE(PG8_SB(0, 0), cB, voffB); PG8_STAGE(PG8_SB(0, 1), cB + hstepB, voffB); PG8_STAGE(PG8_SA(0, 0), cA, voffA); PG8_STAGE(PG8_SA(0, 1), cA + hstepA, voffA);
    if (wr == 1) PG8_BAR;
    PG8_WAIT_V(2); PG8_BAR;
    PG8_STAGE(PG8_SB(1, 0), cB + kstep, voffB); PG8_STAGE(PG8_SA(1, 0), cA + kstep, voffA); PG8_STAGE(PG8_SB(1, 1), cB + hstepB + kstep, voffB);
    PG8_WAIT_V(6); PG8_BAR;
    for (;;) {
        const bool has_next = S.next(ui + 1, nxt);
        const char* nA = has_next ? nxt.a : cA; const char* nB = has_next ? nxt.b : cB;
        for (int t = 0; t < nt; t += 2) {
            const bool last = (t == nt - 2);
            const char* a1 = cA + (size_t)(t + 1) * kstep;
            const char* a2 = last ? nA : cA + (size_t)(t + 2) * kstep; const char* b2 = last ? nB : cB + (size_t)(t + 2) * kstep;
            const char* a3 = a2 + kstep; const char* b3 = b2 + kstep;
            PG8_LDB(B0, 0, 0); PG8_LDB(B1, 0, 1); PG8_SCHED; PG8_LDA(At, 0, 0); PG8_STAGE(PG8_SA(1, 1), a1 + hstepA, voffA);
            PG8_WAIT_V(8); PG8_WAIT_L(0); PG8_BAR; PG8_MMA(0, 0, At, B0); PG8_MMA(0, 1, At, B1); PG8_BAR; PG8_SCHED;
            PG8_LDA(At, 0, 1); PG8_STAGE(PG8_SB(0, 0), b2, voffB); PG8_STAGE(PG8_SB(0, 1), b2 + hstepB, voffB); PG8_STAGE(PG8_SA(0, 0), a2, voffA);
            PG8_WAIT_V(8); PG8_WAIT_L(0); PG8_BAR; PG8_MMA(1, 0, At, B0); PG8_MMA(1, 1, At, B1); PG8_BAR; PG8_SCHED;
            PG8_LDB(B0, 1, 0); PG8_LDB(B1, 1, 1); PG8_SCHED; PG8_LDA(At, 1, 0); PG8_STAGE(PG8_SA(0, 1), a2 + hstepA, voffA);
            PG8_WAIT_V(8); PG8_WAIT_L(0); PG8_BAR; PG8_MMA(0, 0, At, B0); PG8_MMA(0, 1, At, B1); PG8_BAR; PG8_SCHED;
            PG8_LDA(At, 1, 1); PG8_STAGE(PG8_SB(1, 0), b3, voffB); PG8_STAGE(PG8_SB(1, 1), b3 + hstepB, voffB); PG8_STAGE(PG8_SA(1, 0), a3, voffA);
            PG8_WAIT_V(8); PG8_WAIT_L(0); PG8_BAR; PG8_MMA(1, 0, At, B0); PG8_MMA(1, 1, At, B1); PG8_BAR; PG8_SCHED;
        }
        if (wr == 0) PG8_BAR;
        if constexpr (!Epi::AFTER_DRAIN) { int fr_ = fr, fq_ = fq; asm volatile("" : "+v"(fr_), "+v"(fq_)); E(acc, cur, wr, wc, fr_, fq_); }
        if (!has_next) break;
#pragma unroll
        for (int a = 0; a < 2; ++a)
#pragma unroll
            for (int b = 0; b < 2; ++b)
#pragma unroll
                for (int m = 0; m < 4; ++m)
#pragma unroll
                    for (int n = 0; n < 2; ++n) acc[a][b][m][n] = (f32x4){0.f, 0.f, 0.f, 0.f};
        cur = nxt; cA = nA; cB = nB; ++ui;
        if (wr == 1) PG8_BAR;
    }
    PG8_WAIT_V(0);
    PG8_BAR;
    if constexpr (Epi::AFTER_DRAIN) { int fr_ = fr, fq_ = fq; asm volatile("" : "+v"(fr_), "+v"(fq_)); E.fused(acc, cur, wr, wc, fr_, fq_, lds, wid, lane); }
#undef PG8_SA
#undef PG8_SB
#undef PG8_STAGE
#undef PG8_LDA
#undef PG8_LDB
#undef PG8_MMA
#undef PG8_WAIT_V
#undef PG8_WAIT_L
#undef PG8_BAR
#undef PG8_SCHED
}
}

#define XB_TMO      128
#define XB_XCNT(j)  (256  + 64 * (j))
#define XB_XSUB(j)  (1280 + 64 * (j))
#define XB_XGEN(j)  (2304 + 64 * (j))
#define XB_TOP      3328
#define XB_TOPGEN   3392
#define XCD_BAR_WORDS 3456
#define XB_SPIN_CAP (1u << 22)
__device__ __forceinline__ unsigned xb_ld(unsigned* p)              { return __hip_atomic_load(p, __ATOMIC_RELAXED, __HIP_MEMORY_SCOPE_AGENT); }
__device__ __forceinline__ unsigned xb_add(unsigned* p, unsigned v) { return __hip_atomic_fetch_add(p, v, __ATOMIC_RELAXED, __HIP_MEMORY_SCOPE_AGENT); }
__device__ __forceinline__ unsigned xb_xcc_id() { return (unsigned)__builtin_amdgcn_s_getreg((3 << 11) | 20) & 0xFu; }
#define XB_SPIN(cond, bar) do { unsigned _sp = 0; while (cond) { __builtin_amdgcn_s_sleep(1); \
    if ((++_sp & 255u) == 0u) { if (xb_ld(&(bar)[XB_TMO])) break; if (_sp > XB_SPIN_CAP) { atomicAdd(&(bar)[XB_TMO], 1u); break; } } } } while (0)
struct XcdBarrier { unsigned* bar; unsigned x; volatile LAS unsigned* st; };
__device__ __forceinline__ XcdBarrier xcd_barrier_post(unsigned* bar, volatile LAS unsigned* st) {
    XcdBarrier b; b.bar = bar; b.x = xb_xcc_id(); b.st = st;
    if (threadIdx.x == 0) (void)xb_add(&bar[XB_XCNT(b.x)], 1u);
    return b;
}
__device__ __forceinline__ void xcd_barrier_complete(unsigned* bar, unsigned x, unsigned& nloc, unsigned& nx) {
    const unsigned G = gridDim.x * gridDim.y * gridDim.z;
    unsigned sum, cnt, mine, sp = 0u;
    for (;;) {
        sum = 0u; cnt = 0u; mine = 0u;
#pragma unroll
        for (unsigned j = 0; j < 16; ++j) { const unsigned c = xb_ld(&bar[XB_XCNT(j)]); sum += c; cnt += (c > 0u) ? 1u : 0u; mine = (j == x) ? c : mine; }
        if (sum == G) break;
        __builtin_amdgcn_s_sleep(1);
        if ((++sp & 255u) == 0u) { if (xb_ld(&bar[XB_TMO])) break; if (sp > XB_SPIN_CAP) { atomicAdd(&bar[XB_TMO], 1u); break; } }
    }
    nloc = mine > 0u ? mine : 1u; nx = cnt > 0u ? cnt : 1u;
}
__device__ __forceinline__ void xcd_barrier(const XcdBarrier& b) {
    asm volatile("s_waitcnt vmcnt(0)" ::: "memory");
    __syncthreads();
    if (threadIdx.x == 0) {
        unsigned* bar = b.bar;
        __builtin_amdgcn_s_waitcnt(0);
        unsigned nloc = b.st[0], nx = b.st[1];
        if (nloc == 0u) { xcd_barrier_complete(bar, b.x, nloc, nx); b.st[0] = nloc; b.st[1] = nx; }
        const unsigned old = xb_add(&bar[XB_XSUB(b.x)], 1u);
        const unsigned gen = old / nloc;
        if (old + 1u == (gen + 1u) * nloc) {
            __builtin_amdgcn_fence(__ATOMIC_RELEASE, "agent");
            asm volatile("s_waitcnt vmcnt(0)" ::: "memory");
            const unsigned og = xb_add(&bar[XB_TOP], 1u);
            const unsigned tg = og / nx;
            if (og + 1u == (tg + 1u) * nx) xb_add(&bar[XB_TOPGEN], 1u);
            else XB_SPIN(xb_ld(&bar[XB_TOPGEN]) == tg, bar);
            __builtin_amdgcn_fence(__ATOMIC_ACQUIRE, "agent");
            xb_add(&bar[XB_XGEN(b.x)], 1u);
            asm volatile("s_waitcnt vmcnt(0)" ::: "memory");
        } else {
            XB_SPIN(xb_ld(&bar[XB_XGEN(b.x)]) == gen, bar);
            __builtin_amdgcn_fence(__ATOMIC_ACQUIRE, "agent");
            asm volatile("s_waitcnt vmcnt(0)" ::: "memory");
        }
    }
    __syncthreads();
}

struct Frame {
    const float* const* in;
    unsigned char* ws; float* out;
    int tid, lane, wave, G, bid;
};
#define WSP(T, off) ((T*)(F.ws + (off)))

enum { M_FOLD = 0, M_INPROJ, M_FC1, M_DFT, M_GATES, M_WOUT, M_FC2, M_WOUTC, M_FC2C, M_CDFT };

struct Sched {
    unsigned char* ws; int mode, l, G, c, total;
    __device__ __forceinline__ void init(unsigned char* ws_, int mode_, int l_, int G_, int c_) {
        ws = ws_; mode = mode_; l = l_; G = G_; c = c_;
        const int nM = (l == 0) ? 34 : 32;
        switch (mode) {
            case M_FOLD: total = 64; break;
            case M_INPROJ: total = 34 * 12 + 8 * 34; break;
            case M_FC1: total = nM * 32; break;
            case M_DFT: total = 256; break;
            case M_GATES: total = 272; break;
            case M_CDFT: total = 4; break;
            case M_WOUT: total = 256; break;
            case M_FC2: total = 256; break;
            case M_WOUTC: total = 64; break;
            default: total = 128; break;
        }
    }
    __device__ __forceinline__ bool next(int i, pg8::Unit& u) const {
        int L = i * G + c;
        if (mode == M_CDFT && G == 256) L -= 16;
        if (L < 0 || L >= total) return false;
        const int nM = (l == 0) ? 34 : 32;
        u.aux = 0;
        switch (mode) {
            case M_FOLD: { const int lw = L >> 5, r = L & 31; u.pm = r >> 3; u.pn = r & 7; u.aux = lw;
                u.a = (const char*)(ws + O_WFOLD) + ((size_t)lw * 1024 + u.pm * 256) * 512 * 2; u.b = (const char*)(ws + O_WF) + ((size_t)lw * 2048 + u.pn * 256) * 512 * 2; } break;
            case M_INPROJ: {
                if (L < 408) { pg8::tile_of(L, 34, 12, u.pm, u.pn); u.aux = 0;
                    u.a = (const char*)(ws + O_U) + (size_t)u.pm * 256 * 2048 * 2; u.b = (const char*)(ws + O_WIN) + ((size_t)l * 5120 + u.pn * 256) * 2048 * 2; }
                else { pg8::tile_of(L - 408, 8, 34, u.pm, u.pn); u.aux = 1;
                    u.a = (const char*)(ws + O_WIN) + ((size_t)l * 5120 + 3072 + u.pm * 256) * 2048 * 2; u.b = (const char*)(ws + O_U) + (size_t)u.pn * 256 * 2048 * 2; }
            } break;
            case M_FC1: { pg8::tile_of(L, nM, 32, u.pm, u.pn);
                u.a = (const char*)(ws + O_U) + (size_t)u.pm * 256 * 2048 * 2; u.b = (const char*)(ws + O_W1) + ((size_t)l * 8192 + u.pn * 256) * 2048 * 2; } break;
            case M_DFT: { const int ks = L >> 5, r = L & 31, b = r >> 4, mt = (r & 15) >> 1, pn = r & 1; u.pm = b * 8 + mt; u.pn = pn; u.aux = ks;
                u.a = (const char*)(ws + O_DFT) + ((size_t)mt * 256 * 8192 + ks * 1024) * 2; u.b = (const char*)(ws + O_ABT) + ((size_t)(b * 512 + pn * 256) * 8192 + ks * 1024) * 2; } break;
            case M_GATES: { u.pm = L >> 3; u.pn = L & 7; u.aux = 0; const int blk = u.pn & 3;
                    u.a = (const char*)(ws + O_XC) + ((size_t)u.pm * 256 * 512 + blk * 128) * 2; u.b = (const char*)(ws + O_WG) + (((size_t)l * 2048 + u.pn * 256) * 512 + blk * 128) * 2; } break;
            case M_CDFT: { const int b = L >> 1, pn = L & 1; u.pm = 32 + b; u.pn = pn; u.aux = 1;
                    u.a = (const char*)(ws + O_DFTC); u.b = (const char*)(ws + O_ABTC) + (size_t)(b * 512 + pn * 256) * 512 * 2; } break;
            case M_WOUT: { pg8::tile_of(L, 32, 8, u.pm, u.pn);
                u.a = (const char*)(ws + O_MIX) + (size_t)u.pm * 256 * 2048 * 2; u.b = (const char*)(ws + O_WOUT) + ((size_t)l * 2048 + u.pn * 256) * 2048 * 2; } break;
            case M_FC2: { pg8::tile_of(L, 32, 8, u.pm, u.pn);
                u.a = (const char*)(ws + O_H) + (size_t)u.pm * 256 * 8192 * 2; u.b = (const char*)(ws + O_W2) + ((size_t)l * 2048 + u.pn * 256) * 8192 * 2; } break;
            case M_WOUTC: { const int ks = L >> 4, r = L & 15; u.pm = 32 + (r >> 3); u.pn = r & 7; u.aux = ks;
                u.a = (const char*)(ws + O_MIX) + ((size_t)u.pm * 256 * 2048 + ks * 512) * 2; u.b = (const char*)(ws + O_WOUT) + (((size_t)l * 2048 + u.pn * 256) * 2048 + ks * 512) * 2; } break;
            default: { const int ks = L >> 4, r = L & 15; u.pm = 32 + (r >> 3); u.pn = r & 7; u.aux = ks;
                u.a = (const char*)(ws + O_H) + ((size_t)u.pm * 256 * 8192 + ks * 1024) * 2; u.b = (const char*)(ws + O_W2) + (((size_t)l * 2048 + u.pn * 256) * 8192 + ks * 1024) * 2; } break;
        }
        return true;
    }
};

__device__ __forceinline__ float bperm_f(int byteidx, float v) { return __int_as_float(__builtin_amdgcn_ds_bpermute(byteidx, __float_as_int(v))); }
__device__ __forceinline__ void xpose_f32(const f32x4& v0, const f32x4& v1, f32x4& oA, f32x4& oB, int lane) {
    const int srcA = ((lane >> 3) + 16 * (lane & 3)) * 4, srcB = srcA + 32; const bool hi = (lane >> 2) & 1;
#pragma unroll
    for (int j = 0; j < 4; ++j) { const float a0 = bperm_f(srcA, v0[j]), a1 = bperm_f(srcA, v1[j]), b0 = bperm_f(srcB, v0[j]), b1 = bperm_f(srcB, v1[j]); oA[j] = hi ? a1 : a0; oB[j] = hi ? b1 : b0; }
}
__device__ __forceinline__ u32x4 xpose_b16(const u32x4& w, int lane) {
    const int src = ((lane >> 2) + 16 * (lane & 3)) * 4; u32x4 o;
    o.x = (unsigned)__builtin_amdgcn_ds_bpermute(src, (int)w.x); o.y = (unsigned)__builtin_amdgcn_ds_bpermute(src, (int)w.y); o.z = (unsigned)__builtin_amdgcn_ds_bpermute(src, (int)w.z); o.w = (unsigned)__builtin_amdgcn_ds_bpermute(src, (int)w.w);
    return o;
}

struct EpiB {
    static constexpr bool PERM = true, AFTER_DRAIN = false;
    unsigned char* ws; const float* const* in; int mode, l;
    __device__ __forceinline__ void operator()(const f32x4 (&acc)[2][2][4][2], const pg8::Unit& u, int wr, int wc, int fr, int fq) const {
        bf16* base; size_t ld; const float* bias = nullptr; bool vtb = false;
        if (mode == M_FOLD) { base = (bf16*)(ws + O_WIN) + ((size_t)u.aux * 5120 + 4096 + u.pm * 256) * 2048 + u.pn * 256; ld = 2048; }
        else if (mode == M_FC1) { base = (bf16*)(ws + O_H) + (size_t)u.pm * 256 * 8192 + u.pn * 256; ld = 8192; bias = in[I_BFC1] + (size_t)l * 8192 + u.pn * 256; }
        else {
            if (u.aux == 0) { base = (bf16*)(ws + O_P1) + (size_t)u.pm * 256 * NP1 + u.pn * 256; ld = NP1; }
            else if (u.pm < 4) { base = (bf16*)(ws + O_VT) + (size_t)(u.pn * 4) * 65536 + (size_t)u.pm * 256 * 64; ld = 64; vtb = true; }
            else { const int q = u.pm - 4, part = q >> 1, nb = (q & 1) * 256;
                if (u.pn < 32) { const int bb = u.pn >> 4, t0 = (u.pn & 15) * 256; base = (bf16*)(ws + O_ABT) + ((size_t)(bb * 512 + nb) * 2 + part) * 4096 + t0; ld = 8192; }
                else { const int bb = u.pn - 32; base = (bf16*)(ws + O_ABTC) + ((size_t)(bb * 512 + nb) * 2 + part) * 256; ld = 512; } }
        }
        const int lane = fr + 16 * fq;
        const int row0 = wr * 64 + (lane >> 2), col0 = wc * 32 + 8 * fq, scol0 = wc * 32 + 8 * (lane & 3);
        f32x4 bv[2][2];
#pragma unroll
        for (int bj = 0; bj < 2; ++bj)
#pragma unroll
            for (int n = 0; n < 2; ++n) bv[bj][n] = bias ? *(const f32x4*)(bias + col0 + bj * 128 + 4 * n) : (f32x4){0.f, 0.f, 0.f, 0.f};
#pragma unroll
        for (int ai = 0; ai < 2; ++ai)
#pragma unroll
            for (int m = 0; m < 4; ++m) { bf16* rowp = base + (size_t)(row0 + ai * 128 + m * 16) * ld + (vtb ? (size_t)(scol0 >> 6) * 65536 + (scol0 & 63) : (size_t)scol0);
                const size_t bjs = vtb ? 131072 : 128;
#pragma unroll
                for (int bj = 0; bj < 2; ++bj) { f32x4 v0 = acc[ai][bj][m][0] + bv[bj][0], v1 = acc[ai][bj][m][1] + bv[bj][1];
                    if (mode == M_FC1) {
#pragma unroll
                        for (int j = 0; j < 4; ++j) { const float a = fmaxf(v0[j], 0.f), b = fmaxf(v1[j], 0.f); v0[j] = a * a; v1[j] = b * b; } }
                    u32x4 w; w.x = pk2(v0[0], v0[1]); w.y = pk2(v0[2], v0[3]); w.z = pk2(v1[0], v1[1]); w.w = pk2(v1[2], v1[3]);
                    *(u32x4*)(rowp + bj * bjs) = xpose_b16(w, lane); } }
    }
};

struct EpiF {
    static constexpr bool PERM = false, AFTER_DRAIN = false;
    unsigned char* ws; const float* const* in; int mode, l;
    __device__ __forceinline__ void operator()(const f32x4 (&acc)[2][2][4][2], const pg8::Unit& u, int wr, int wc, int fr, int fq) const {
        const int lane = fr + 16 * fq;
        const int row0 = wr * 64 + fr, col0 = wc * 32 + 4 * fq, srow0 = wr * 64 + (lane >> 3), scol0 = wc * 32 + 4 * (lane & 7);
        if (mode == M_DFT || mode == M_WOUTC || mode == M_FC2C || mode == M_CDFT) {
            const size_t ldp = (mode == M_WOUTC || mode == M_FC2C) ? 2048 : 512;
            float* base = (mode == M_DFT) ? (float*)(ws + O_PART) + ((size_t)u.aux * 4096 + u.pm * 256) * 512 + u.pn * 256
                        : (mode == M_CDFT) ? (float*)(ws + O_PART) + 16777216 + ((size_t)(u.pm - 32) * 256) * 512 + u.pn * 256
                        : (float*)(ws + O_CPART) + ((size_t)u.aux * 512 + (u.pm - 32) * 256) * 2048 + u.pn * 256;
#pragma unroll
            for (int ai = 0; ai < 2; ++ai)
#pragma unroll
                for (int m = 0; m < 4; ++m) { float* rowp = base + (size_t)(srow0 + ai * 128 + m * 16) * ldp + scol0;
#pragma unroll
                    for (int bj = 0; bj < 2; ++bj) { f32x4 oA, oB; xpose_f32(acc[ai][bj][m][0], acc[ai][bj][m][1], oA, oB, lane);
                        if (mode == M_DFT) { bf16* hp = (bf16*)(ws + O_PART) + (rowp - (float*)(ws + O_PART));
                            u32x2 wA, wB; wA.x = pk2(oA[0], oA[1]); wA.y = pk2(oA[2], oA[3]); wB.x = pk2(oB[0], oB[1]); wB.y = pk2(oB[2], oB[3]);
                            *(u32x2*)(hp + bj * 128) = wA; *(u32x2*)(hp + 8 * ldp + bj * 128) = wB; }
                        else { *(f32x4*)(rowp + bj * 128) = oA; *(f32x4*)(rowp + 8 * ldp + bj * 128) = oB; } } }
        } else if (mode == M_GATES) {
            const int d = u.pn >> 2, blk = u.pn & 3;
            const float* ba = in[I_BA] + ((size_t)l * 2 + d) * 512; const float* bx = in[I_BX] + ((size_t)l * 2 + d) * 512; const float* lam = (const float*)(ws + O_SPT) + ((size_t)l * 2 + d) * 512;
            const bf16* xc = (const bf16*)(ws + O_XC);
            unsigned* Ao = (unsigned*)(ws + O_AA) + (size_t)d * MT * 512;
            f32x4 bav[2], bxv[2], sp[2];
#pragma unroll
            for (int n = 0; n < 2; ++n) { const int ch = blk * 128 + col0 + 16 * n; bav[n] = *(const f32x4*)(ba + ch); bxv[n] = *(const f32x4*)(bx + ch); sp[n] = *(const f32x4*)(lam + ch); }
            const int sch = blk * 128 + scol0;
#pragma unroll
            for (int ai = 0; ai < 2; ++ai)
#pragma unroll
                for (int m = 0; m < 4; ++m) {
                    const size_t tok = (size_t)u.pm * 256 + srow0 + ai * 128 + m * 16;
                    const u32x2 xa = __builtin_nontemporal_load((const u32x2*)(xc + tok * 512 + sch)), xb = __builtin_nontemporal_load((const u32x2*)(xc + (tok + 8) * 512 + sch));
                    f32x4 av[2], uv[2];
#pragma unroll
                    for (int n = 0; n < 2; ++n)
#pragma unroll
                        for (int j = 0; j < 4; ++j) {
                            const float r = sigmoid_fast(acc[ai][0][m][n][j] + bav[n][j]);
                            const float ig = sigmoid_fast(acc[ai][1][m][n][j] + bxv[n][j]);
                            const float la = sp[n][j] * r;
                            av[n][j] = la;
                            const float aa = __builtin_amdgcn_exp2f(1.4426950408889634f * la);
                            const float x2 = 2.0f * la;
                            const float ser = -x2 * (1.0f + x2 * (0.5f + x2 * (0.16666667f + x2 * (0.041666668f + x2 * (0.0083333338f + x2 * 0.0013888889f)))));
                            const float om = (x2 > -0.35f) ? ser : 1.0f - aa * aa;
                            uv[n][j] = __builtin_amdgcn_sqrtf(fmaxf(om, 0.f)) * ig;
                        }
                    f32x4 aA, aB, uA, uB; xpose_f32(av[0], av[1], aA, aB, lane); xpose_f32(uv[0], uv[1], uA, uB, lane);
                    uA[0] *= bf2f(xa.x & 0xffffu); uA[1] *= bf2f(xa.x >> 16); uA[2] *= bf2f(xa.y & 0xffffu); uA[3] *= bf2f(xa.y >> 16);
                    uB[0] *= bf2f(xb.x & 0xffffu); uB[1] *= bf2f(xb.x >> 16); uB[2] *= bf2f(xb.y & 0xffffu); uB[3] *= bf2f(xb.y >> 16);
                    u32x4 wA, wB; wA.x = pk2(aA[0], uA[0]); wA.y = pk2(aA[1], uA[1]); wA.z = pk2(aA[2], uA[2]); wA.w = pk2(aA[3], uA[3]);
                    wB.x = pk2(aB[0], uB[0]); wB.y = pk2(aB[1], uB[1]); wB.z = pk2(aB[2], uB[2]); wB.w = pk2(aB[3], uB[3]);
                    *(u32x4*)(Ao + tok * 512 + sch) = wA; *(u32x4*)(Ao + (tok + 8) * 512 + sch) = wB;
                    asm volatile("" ::: "memory");
                }
        } else {
            const int mr = (u.pm < 16) ? 0 : (u.pm < 32 ? 1 : 2);
            const float* gp = (const float*)(ws + O_MODV) + ((size_t)l * 3 + mr) * 12288 + (mode == M_WOUT ? 4096 : 10240) + u.pn * 256;
            const float* bias = (mode == M_FC2) ? in[I_BFC2] + (size_t)l * 2048 + u.pn * 256 : nullptr;
            const float* xs;
            if (mode == M_WOUT && l == 0) xs = (u.pm < 32) ? in[I_X] + (size_t)u.pm * 256 * D : in[I_CTX] + (size_t)(u.pm - 32) * 256 * D;
            else xs = (const float*)(ws + O_X) + (size_t)u.pm * 256 * D;
            xs += u.pn * 256;
            float* yo = (float*)(ws + O_Y) + (size_t)u.pm * 256 * D + u.pn * 256;
            f32x4 gv[2][2], bv[2][2];
#pragma unroll
            for (int bj = 0; bj < 2; ++bj)
#pragma unroll
                for (int n = 0; n < 2; ++n) { gv[bj][n] = *(const f32x4*)(gp + col0 + bj * 128 + n * 16); bv[bj][n] = bias ? *(const f32x4*)(bias + col0 + bj * 128 + n * 16) : (f32x4){0.f, 0.f, 0.f, 0.f}; }
#pragma unroll
            for (int ai = 0; ai < 2; ++ai)
#pragma unroll
                for (int m = 0; m < 4; ++m) { const size_t off = (size_t)(srow0 + ai * 128 + m * 16) * D + scol0;
#pragma unroll
                    for (int bj = 0; bj < 2; ++bj) { f32x4 tA, tB; xpose_f32(gv[bj][0] * (acc[ai][bj][m][0] + bv[bj][0]), gv[bj][1] * (acc[ai][bj][m][1] + bv[bj][1]), tA, tB, lane);
                        const f32x4 xA = *(const f32x4*)(xs + off + bj * 128), xB = *(const f32x4*)(xs + off + 8 * D + bj * 128);
                        *(f32x4*)(yo + off + bj * 128) = xA * ALPHA + tA; *(f32x4*)(yo + off + 8 * D + bj * 128) = xB * ALPHA + tB; }
                    asm volatile("" ::: "memory"); }
        }
    }
};

struct PanelStats {
    unsigned long long* xbuf; unsigned* cnt;
    __device__ __forceinline__ void run(const f32x4 (&v)[2][2][4][2], const pg8::Unit& u, int wr, int wc, LAS unsigned char* lds, int wid, int lane) const {
        LAS f32x2* P = (LAS f32x2*)lds;
        LAS f32x2* S = (LAS f32x2*)(lds + 8192);
        const int rl = lane >> 3, cl = lane & 7;
#pragma unroll
        for (int ai = 0; ai < 2; ++ai)
#pragma unroll
            for (int m = 0; m < 4; ++m)
#pragma unroll
                for (int h = 0; h < 2; ++h) {
                    const f32x4 x0 = v[ai][0][m][h], x1 = v[ai][1][m][h];
                    float s = ((x0[0] + x0[1]) + (x0[2] + x0[3])) + ((x1[0] + x1[1]) + (x1[2] + x1[3]));
                    s += __shfl_xor(s, 1); s += __shfl_xor(s, 2); s += __shfl_xor(s, 4);
                    const float mw = s * (1.0f / 64.0f);
                    const f32x4 d0 = x0 - mw, d1 = x1 - mw;
                    float q = ((d0[0] * d0[0] + d0[1] * d0[1]) + (d0[2] * d0[2] + d0[3] * d0[3])) + ((d1[0] * d1[0] + d1[1] * d1[1]) + (d1[2] * d1[2] + d1[3] * d1[3]));
                    q += __shfl_xor(q, 1); q += __shfl_xor(q, 2); q += __shfl_xor(q, 4);
                    if (cl == 0) P[(ai * 128 + wr * 64 + m * 16 + h * 8 + rl) * 4 + wc] = (f32x2){mw, q};
                }
        asm volatile("s_waitcnt lgkmcnt(0)" ::: "memory"); __builtin_amdgcn_s_barrier(); asm volatile("" ::: "memory");
        const int row = wid * 32 + (lane & 31);
        if (lane < 32) {
            const f32x2 a = P[row * 4 + 0], b = P[row * 4 + 1], c = P[row * 4 + 2], d = P[row * 4 + 3];
            const float mt = (a.x + b.x + c.x + d.x) * 0.25f;
            const float da = a.x - mt, db = b.x - mt, dc = c.x - mt, dd = d.x - mt;
            const float m2 = (a.y + b.y) + (c.y + d.y) + 64.0f * ((da * da + db * db) + (dc * dc + dd * dd));
            __hip_atomic_store(xbuf + ((size_t)(u.pm * 256 + row) * 8 + u.pn), ((unsigned long long)__float_as_uint(m2) << 32) | __float_as_uint(mt), __ATOMIC_RELAXED, __HIP_MEMORY_SCOPE_AGENT);
        }
        asm volatile("s_waitcnt vmcnt(0)" ::: "memory");
        if (lane == 0) __hip_atomic_fetch_add(cnt + 64 * u.pm, 1u, __ATOMIC_RELAXED, __HIP_MEMORY_SCOPE_AGENT);
        if (wid == 0) {
            unsigned sp = 0;
            while ((unsigned)__builtin_amdgcn_readfirstlane(__hip_atomic_load(cnt + 64 * u.pm, __ATOMIC_RELAXED, __HIP_MEMORY_SCOPE_AGENT)) < 64u) { __builtin_amdgcn_s_sleep(2); if (++sp > (1u << 22)) break; }
            __builtin_amdgcn_fence(__ATOMIC_ACQUIRE, "agent");
        }
        asm volatile("s_waitcnt vmcnt(0) lgkmcnt(0)" ::: "memory"); __builtin_amdgcn_s_barrier(); asm volatile("" ::: "memory");
        if (lane < 32) {
            const unsigned long long* slot = xbuf + (size_t)(u.pm * 256 + row) * 8; float mt[8], m2[8]; float ms = 0.f;
#pragma unroll
            for (int t = 0; t < 8; ++t) { const unsigned long long w = __hip_atomic_load(slot + t, __ATOMIC_RELAXED, __HIP_MEMORY_SCOPE_AGENT); mt[t] = __uint_as_float((unsigned)w); m2[t] = __uint_as_float((unsigned)(w >> 32)); ms += mt[t]; }
            const float mean = ms * 0.125f; float q = 0.f;
#pragma unroll
            for (int t = 0; t < 8; ++t) { const float dm = mt[t] - mean; q += m2[t] + 256.0f * dm * dm; }
            S[row] = (f32x2){mean, 1.0f / sqrtf(q * (1.0f / 2048.0f) + LN_EPS)};
        }
        asm volatile("s_waitcnt lgkmcnt(0)" ::: "memory"); __builtin_amdgcn_s_barrier(); asm volatile("" ::: "memory");
    }
};
struct EpiLN {
    static constexpr bool PERM = false, AFTER_DRAIN = true;
    unsigned char* ws; const float* const* in; float* out; int mode, l; int dry;
    __device__ __forceinline__ void operator()(const f32x4 (&)[2][2][4][2], const pg8::Unit&, int, int, int, int) const {}
    __device__ __forceinline__ void fused(f32x4 (&acc)[2][2][4][2], const pg8::Unit& u, int wr, int wc, int fr, int fq, LAS unsigned char* lds, int wid, int lane) const {
        const int col0 = wc * 32 + 4 * fq;
        const int rl = lane >> 3, scol = wc * 32 + 4 * (lane & 7);
        const int mr = (u.pm < 16) ? 0 : 1;
        const float* modl = (const float*)(ws + O_MODV) + ((size_t)l * 3 + mr) * 12288;
        const float* gp = modl + (mode == M_WOUT ? 4096 : 10240) + u.pn * 256;
        const float* bias = (mode == M_FC2) ? in[I_BFC2] + (size_t)l * 2048 + u.pn * 256 : nullptr;
        const float* xs = (mode == M_WOUT && l == 0) ? in[I_X] + (size_t)u.pm * 256 * D : (const float*)(ws + O_X) + (size_t)u.pm * 256 * D;
        xs += u.pn * 256;
        const LAS f32x2* S = (const LAS f32x2*)(lds + 8192);
#pragma unroll
        for (int ai = 0; ai < 2; ++ai)
#pragma unroll
            for (int bj = 0; bj < 2; ++bj) {
                int rw0 = wr * 64 + ai * 128 + rl, sc0 = scol + bj * 128; asm volatile("" : "+v"(rw0), "+v"(sc0));
                f32x4 xv[4][2];
#pragma unroll
                for (int m = 0; m < 4; ++m)
#pragma unroll
                    for (int h = 0; h < 2; ++h) xv[m][h] = __builtin_nontemporal_load((const f32x4*)(xs + (size_t)(rw0 + m * 16 + 8 * h) * D + sc0));
                const f32x4 g0 = *(const f32x4*)(gp + col0 + bj * 128), g1 = *(const f32x4*)(gp + col0 + bj * 128 + 16);
                const f32x4 b0 = bias ? *(const f32x4*)(bias + col0 + bj * 128) : (f32x4){0.f, 0.f, 0.f, 0.f}, b1 = bias ? *(const f32x4*)(bias + col0 + bj * 128 + 16) : (f32x4){0.f, 0.f, 0.f, 0.f};
#pragma unroll
                for (int m = 0; m < 4; ++m) { f32x4 tA, tB; xpose_f32(g0 * (acc[ai][bj][m][0] + b0), g1 * (acc[ai][bj][m][1] + b1), tA, tB, lane);
                    acc[ai][bj][m][0] = xv[m][0] * ALPHA + tA; acc[ai][bj][m][1] = xv[m][1] * ALPHA + tB; }
                asm volatile("" : "+v"(acc[ai][bj][0][0]), "+v"(acc[ai][bj][0][1]), "+v"(acc[ai][bj][1][0]), "+v"(acc[ai][bj][1][1]), "+v"(acc[ai][bj][2][0]), "+v"(acc[ai][bj][2][1]), "+v"(acc[ai][bj][3][0]), "+v"(acc[ai][bj][3][1]) :: "memory");
            }
        const int bank = l * 4 + (mode == M_WOUT ? 0 : 2) + (dry ? 8 : 0);
        PanelStats st1{(unsigned long long*)(ws + O_XB), (unsigned*)(ws + O_CNT) + (size_t)bank * 2048};
        const float* gam = (mode == M_WOUT ? in[I_LN1G] : in[I_LN2G]) + (size_t)l * D + u.pn * 256; const float* bet = (mode == M_WOUT ? in[I_LN1B] : in[I_LN2B]) + (size_t)l * D + u.pn * 256;
        const f32x4 gv0 = *(const f32x4*)(gam + scol), gv1 = *(const f32x4*)(gam + scol + 128), bv0 = *(const f32x4*)(bet + scol), bv1 = *(const f32x4*)(bet + scol + 128);
        st1.run(acc, u, wr, wc, lds, wid, lane);
        const bool last = (mode == M_FC2 && l == 1);
        float* xo = (dry ? (float*)(ws + O_PART) : (last ? out : (float*)(ws + O_X))) + (size_t)u.pm * 256 * D + u.pn * 256;
        {
#pragma unroll
            for (int ai = 0; ai < 2; ++ai)
#pragma unroll
                for (int m = 0; m < 4; ++m) { int rw = wr * 64 + ai * 128 + m * 16 + rl; asm volatile("" : "+v"(rw));
#pragma unroll
                    for (int h = 0; h < 2; ++h) { const f32x2 sr = S[rw + 8 * h];
                        const f32x4 a = (acc[ai][0][m][h] - sr.x) * sr.y * gv0 + bv0, b = (acc[ai][1][m][h] - sr.x) * sr.y * gv1 + bv1; acc[ai][0][m][h] = a; acc[ai][1][m][h] = b;
                        if (last) { __builtin_nontemporal_store(a, (f32x4*)(xo + (size_t)(rw + 8 * h) * D + scol)); __builtin_nontemporal_store(b, (f32x4*)(xo + (size_t)(rw + 8 * h) * D + scol + 128)); } }
                    asm volatile("" ::: "memory"); }
        }
        if (last) return;
        PanelStats st2{(unsigned long long*)(ws + O_XB) + 65536, (unsigned*)(ws + O_CNT) + (size_t)(bank + 1) * 2048};
        const float* modn = (mode == M_WOUT) ? modl : (const float*)(ws + O_MODV) + ((size_t)(l + 1) * 3 + mr) * 12288;
        const float* shp = modn + (mode == M_WOUT ? 6144 : 0) + u.pn * 256; const float* scp = modn + (mode == M_WOUT ? 8192 : 2048) + u.pn * 256;
        const f32x4 sh0 = *(const f32x4*)(shp + scol), sh1 = *(const f32x4*)(shp + scol + 128), sc0 = *(const f32x4*)(scp + scol) + 1.0f, sc1 = *(const f32x4*)(scp + scol + 128) + 1.0f;
        st2.run(acc, u, wr, wc, lds, wid, lane);
        bf16* uo = (bf16*)(ws + (dry ? O_Y : O_U)) + (size_t)u.pm * 256 * D + u.pn * 256;
        {
#pragma unroll
            for (int ai = 0; ai < 2; ++ai)
#pragma unroll
                for (int m = 0; m < 4; ++m) { int rw = wr * 64 + ai * 128 + m * 16 + rl; asm volatile("" : "+v"(rw));
#pragma unroll
                    for (int h = 0; h < 2; ++h) { const f32x2 sr = S[rw + 8 * h];
                        *(f32x4*)(xo + (size_t)(rw + 8 * h) * D + scol) = acc[ai][0][m][h]; *(f32x4*)(xo + (size_t)(rw + 8 * h) * D + scol + 128) = acc[ai][1][m][h];
                        const f32x4 a = (acc[ai][0][m][h] - sr.x) * sr.y * sc0 + sh0, b = (acc[ai][1][m][h] - sr.x) * sr.y * sc1 + sh1;
                        u32x2 wa, wb; wa.x = pk2(a[0], a[1]); wa.y = pk2(a[2], a[3]); wb.x = pk2(b[0], b[1]); wb.y = pk2(b[2], b[3]);
                        *(u32x2*)(uo + (size_t)(rw + 8 * h) * D + scol) = wa; *(u32x2*)(uo + (size_t)(rw + 8 * h) * D + scol + 128) = wb; }
                    asm volatile("" ::: "memory"); }
        }
    }
};

__device__ __forceinline__ float wave_sum(float v) {
#pragma unroll
    for (int o = 1; o < 64; o <<= 1) v += __shfl_xor(v, o);
    return v;
}

__device__ __forceinline__ void transpose_item(const float* W, int ldw, int Kd, bf16* WT, LAS float* scr, int k0, int n0s, int n0d, int lane) {
    float tv[32];
#pragma unroll
    for (int i = 0; i < 32; ++i) tv[i] = __builtin_nontemporal_load(&W[(size_t)(k0 + 2 * i + (lane >> 5)) * ldw + n0s + (lane & 31)]);
#pragma unroll
    for (int i = 0; i < 32; ++i) scr[(2 * i + (lane >> 5)) * 33 + (lane & 31)] = tv[i];
    asm volatile("s_waitcnt lgkmcnt(0)" ::: "memory");
    const int c = lane & 7;
#pragma unroll
    for (int j = 0; j < 4; ++j) { const int n = (lane >> 3) + 8 * j; const LAS float* s = scr + (8 * c) * 33 + n;
        u32x4 o; o.x = pk2(s[0 * 33], s[1 * 33]); o.y = pk2(s[2 * 33], s[3 * 33]); o.z = pk2(s[4 * 33], s[5 * 33]); o.w = pk2(s[6 * 33], s[7 * 33]);
        *(u32x4*)(WT + (size_t)(n0d + n) * Kd + k0 + 8 * c) = o; }
    asm volatile("s_waitcnt lgkmcnt(0)" ::: "memory");
}

constexpr int CONV_IA = 32 * 128, CONV_IB = 32 * 64, CONV_IC1 = 32 * 256, CONV_IC2 = 128 * 64, CONV_PER = CONV_IA + CONV_IB + CONV_IC1 + CONV_IC2;
__device__ __forceinline__ void convert_items(const Frame& F, LAS unsigned char* lds, int first, int stride, int base, int end) {
    LAS float* scr = (LAS float*)(lds + 40960 + F.wave * 8448);
    for (int it = base + first; it < end; it += stride) { const int lw = it / CONV_PER; int r = it % CONV_PER;
        if (r < CONV_IA) { const int kb = r >> 7, nb = r & 127, sc = nb * 32; const int dst = sc < 2048 ? sc : (sc < 3072 ? 3072 + (sc - 2048) : 2048 + (sc - 3072));
            transpose_item(F.in[I_WIN] + (size_t)lw * 2048 * 4608, 4608, 2048, WSP(bf16, O_WIN) + (size_t)lw * 5120 * 2048, scr, kb * 64, sc, dst, F.lane); continue; }
        r -= CONV_IA;
        if (r < CONV_IB) { const int kb = r >> 6, nb = r & 63; transpose_item(F.in[I_WOUT] + (size_t)lw * 2048 * 2048, 2048, 2048, WSP(bf16, O_WOUT) + (size_t)lw * 2048 * 2048, scr, kb * 64, nb * 32, nb * 32, F.lane); continue; }
        r -= CONV_IB;
        if (r < CONV_IC1) { const int kb = r >> 8, nb = r & 255; transpose_item(F.in[I_WFC1] + (size_t)lw * 2048 * 8192, 8192, 2048, WSP(bf16, O_W1) + (size_t)lw * 8192 * 2048, scr, kb * 64, nb * 32, nb * 32, F.lane); continue; }
        r -= CONV_IC1;
        { const int kb = r >> 6, nb = r & 63; transpose_item(F.in[I_WFC2] + (size_t)lw * 8192 * 2048, 2048, 8192, WSP(bf16, O_W2) + (size_t)lw * 2048 * 8192, scr, kb * 64, nb * 32, nb * 32, F.lane); }
    }
}

__device__ __forceinline__ void phase_prologue(const Frame& F_, LAS unsigned char* lds) {
    Frame F = F_; F.lane = lane_id_fresh(); asm volatile("" : "+v"(F.lane), "+s"(F.wave)); F.tid = F.wave * 64 + F.lane;
    LAS f32x2* tabL = (LAS f32x2*)lds;
    LAS f32x2* tabC = (LAS f32x2*)(lds + 32768);
    for (int q = F.tid; q < 4096; q += NTHR) { float s, c; sincospif((float)q * (1.0f / 2048.0f), &s, &c); tabL[q] = (f32x2){c, s}; }
    if (F.tid < 128) { float s, c; sincospif((float)F.tid * (1.0f / 64.0f), &s, &c); tabC[F.tid] = (f32x2){c, s}; }
    __syncthreads();
    const int gt = F.bid * NTHR + F.tid, NGT = F.G * NTHR;
    for (int _r = 0; _r < REP_PA; ++_r) { const float sc = 0.00138106793f;
      bf16* Dm = WSP(bf16, O_DFT);
      for (int it = gt; it < 2048 * 1024; it += NGT) { const int k = it >> 10, ch = it & 1023, part = ch >> 9, t0 = (ch & 511) * 8;
          float v[8];
#pragma unroll
          for (int j = 0; j < 8; ++j) { const f32x2 cs = tabL[(k * (t0 + j)) & 4095]; v[j] = part ? -cs.y * sc : cs.x * sc; }
          u32x4 o; o.x = pk2(v[0], v[1]); o.y = pk2(v[2], v[3]); o.z = pk2(v[4], v[5]); o.w = pk2(v[6], v[7]);
          *(u32x4*)(Dm + (size_t)k * 8192 + ch * 8) = o; }
      const float scc = 0.00552427173f;
      bf16* Dc = WSP(bf16, O_DFTC);
      for (int it = gt; it < 256 * 64; it += NGT) { const int k = it >> 6, ch = it & 63, part = ch >> 5, t0 = (ch & 31) * 8;
          float v[8];
#pragma unroll
          for (int j = 0; j < 8; ++j) { const f32x2 cs = tabL[((k * (t0 + j)) & 255) * 16]; v[j] = part ? -cs.y * scc : cs.x * scc; }
          u32x4 o; o.x = pk2(v[0], v[1]); o.y = pk2(v[2], v[3]); o.z = pk2(v[4], v[5]); o.w = pk2(v[6], v[7]);
          *(u32x4*)(Dc + (size_t)k * 512 + ch * 8) = o; } }
    for (int _r = 0; _r < REP_PB; ++_r) { bf16* Wf = WSP(bf16, O_WFOLD);
      for (int it = gt; it < 2 * 1024 * 512; it += NGT) { const int jj = it & 511, np = (it >> 9) & 1023, lw = it >> 19; const int part = np >> 9, nout = np & 511, g = jj >> 7, c = jj & 127;
          const float* fw = F.in[I_FNOW] + ((size_t)lw * 512 + g * 128) * 512 + nout; float s = 0.f;
          for (int m = 0; m < 128; ++m) { const f32x2 cs = tabC[(m * c) & 127]; s += (part ? cs.y : cs.x) * fw[(size_t)m * 512]; }
          Wf[it] = (bf16)(pk2(s, 0.f) & 0xffffu); } }
    for (int it = gt; it < 2048; it += NGT) WSP(float, O_SPT)[it] = -8.0f * log1pf(expf(-F.in[I_LAM][it]));
    { bf16* Wg = WSP(bf16, O_WG);
      for (int it = gt; it < 2 * 2048 * 64; it += NGT) { const int kc = it & 63, n = (it >> 6) & 2047, lw = it >> 17; const int pn = n >> 8, half = (n >> 7) & 1, cc = n & 127, d = pn >> 2, blk = pn & 3, k0 = kc * 8;
          u32x4 o = (u32x4){0u, 0u, 0u, 0u};
          if ((k0 >> 7) == blk) { const float* w = (half ? F.in[I_WX] : F.in[I_WA]) + ((((size_t)lw * 2 + d) * 4 + blk) * 128 + (k0 & 127)) * 128 + cc;
              o.x = pk2(w[0], w[128]); o.y = pk2(w[256], w[384]); o.z = pk2(w[512], w[640]); o.w = pk2(w[768], w[896]); }
          *(u32x4*)(Wg + (size_t)it * 8) = o; } }
    { bf16* Wf = WSP(bf16, O_WF);
      for (int it = gt; it < 2 * 2048 * 64; it += NGT) { const int jc = it & 63, kd = (it >> 6) & 2047, lw = it >> 17;
          const float* w = F.in[I_WIN] + ((size_t)lw * 2048 + kd) * 4608 + 4096 + jc * 8; const f32x4 a = *(const f32x4*)w, b = *(const f32x4*)(w + 4);
          u32x4 o; o.x = pk2(a[0], a[1]); o.y = pk2(a[2], a[3]); o.z = pk2(b[0], b[1]); o.w = pk2(b[2], b[3]);
          *(u32x4*)(Wf + (size_t)it * 8) = o; } }
    for (int _r = 0; _r < REP_PC; ++_r) convert_items(F, lds, F.bid * NWAVES + F.wave, F.G * NWAVES, 0, CONV_IA);
    if (F.G != 256) convert_items(F, lds, F.bid * NWAVES + F.wave, F.G * NWAVES, CONV_IA, 2 * CONV_PER);
    __syncthreads();
    { LAS float* sc = (LAS float*)(lds + 40960);
      LAS float* red = (LAS float*)(lds + 40960 + 24576);
      for (int i = F.tid; i < 3 * 2048; i += NTHR) { const int r = i >> 11, k = i & 2047; const float v = (r < 2) ? F.in[I_C][r * 2048 + k] : F.in[I_CCTX][k]; sc[i] = v * sigmoidf_(v); }
      __syncthreads();
      for (int _r = 0; _r < REP_PD; ++_r) for (int strip = F.bid; strip < 256; strip += F.G) {
          const int lw = strip >> 7, n0 = (strip & 127) * 96;
          if (F.tid < 384) { const int cl = F.tid % 24, rg = F.tid / 24; const float* w = F.in[I_WMOD] + ((size_t)lw * 2048 + rg * 128) * 12288 + n0 + cl * 4;
              f32x4 a0 = (f32x4){0.f, 0.f, 0.f, 0.f}, a1 = a0, a2 = a0;
#pragma unroll 32
              for (int k = 0; k < 128; ++k) { const f32x4 wv = __builtin_nontemporal_load((const f32x4*)(w + (size_t)k * 12288)); const int kk = rg * 128 + k;
                  a0 += wv * sc[kk]; a1 += wv * sc[2048 + kk]; a2 += wv * sc[4096 + kk]; }
#pragma unroll
              for (int j = 0; j < 4; ++j) { red[(rg * 3 + 0) * 96 + cl * 4 + j] = a0[j]; red[(rg * 3 + 1) * 96 + cl * 4 + j] = a1[j]; red[(rg * 3 + 2) * 96 + cl * 4 + j] = a2[j]; } }
          __syncthreads();
          if (F.tid < 288) { const int r = F.tid / 96, cidx = F.tid % 96; float s = F.in[I_BMOD][(size_t)lw * 12288 + n0 + cidx];
              for (int rg = 0; rg < 16; ++rg) s += red[(rg * 3 + r) * 96 + cidx];
              WSP(float, O_MODV)[((size_t)lw * 3 + r) * 12288 + n0 + cidx] = s; }
          __syncthreads();
      } }
}

__device__ __forceinline__ void ln_stats(const f32x4 (&v)[8], float& mean, float& rstd) {
    float s = 0.f;
#pragma unroll
    for (int j = 0; j < 8; ++j) s += (v[j][0] + v[j][1]) + (v[j][2] + v[j][3]);
    mean = wave_sum(s) * (1.0f / D); float q = 0.f;
#pragma unroll
    for (int j = 0; j < 8; ++j) { const f32x4 d = v[j] - mean; q += (d[0] * d[0] + d[1] * d[1]) + (d[2] * d[2] + d[3] * d[3]); }
    rstd = 1.0f / sqrtf(wave_sum(q) * (1.0f / D) + LN_EPS);
}
__device__ __forceinline__ void phase_ln(const Frame& F_, int kind, int row_begin, int nrows, const float* gw_, const float* bw_, float* xdst, bool do_u, const float* modl, int sh_off, int sc_off, int cparts = 0, const float* cres = nullptr, const float* cgate = nullptr, const float* cbias = nullptr) {
    Frame F = F_; F.lane = lane_id_fresh(); asm volatile("" : "+v"(F.lane), "+s"(F.wave)); F.tid = F.wave * 64 + F.lane;
    int gw = F.bid * NWAVES + F.wave, NGW = F.G * NWAVES;
    if (kind == 0 && F.G == 256) { if (F.bid < 64) return; gw -= 64 * NWAVES; NGW -= 64 * NWAVES; }
    for (int m = row_begin + gw; m < nrows; m += NGW) {
        const float* src;
        if (kind == 0) src = (m < ML) ? F.in[I_X] + (size_t)m * D : F.in[I_CTX] + (size_t)(m - ML) * D;
        else src = WSP(const float, O_Y) + (size_t)m * D;
        f32x4 v[8];
        if (cparts > 0 && m >= ML) {
            const float* cp = WSP(const float, O_CPART) + (size_t)(m - ML) * D; const float* rs = cres + (size_t)(m - ML) * D;
#pragma unroll
            for (int j = 0; j < 8; ++j) v[j] = cbias ? *(const f32x4*)(cbias + j * 256 + F.lane * 4) : (f32x4){0.f, 0.f, 0.f, 0.f};
#pragma unroll 1
            for (int ks = 0; ks < cparts; ks += 2) {
                f32x4 p0[8], p1[8];
#pragma unroll
                for (int j = 0; j < 8; ++j) { p0[j] = __builtin_nontemporal_load((const f32x4*)(cp + (size_t)ks * 512 * D + j * 256 + F.lane * 4)); p1[j] = __builtin_nontemporal_load((const f32x4*)(cp + (size_t)(ks + 1) * 512 * D + j * 256 + F.lane * 4)); }
#pragma unroll
                for (int j = 0; j < 8; ++j) v[j] += p0[j] + p1[j];
                asm volatile("" ::: "memory"); }
#pragma unroll
            for (int j = 0; j < 8; ++j) { const int co = j * 256 + F.lane * 4; v[j] = *(const f32x4*)(rs + co) * ALPHA + *(const f32x4*)(cgate + co) * v[j]; }
        } else {
#pragma unroll
        for (int j = 0; j < 8; ++j) v[j] = __builtin_nontemporal_load((const f32x4*)(src + j * 256 + F.lane * 4));
        }
        float mean, rstd;
        if (kind == 1) {
            ln_stats(v, mean, rstd);
#pragma unroll
            for (int j = 0; j < 8; ++j) { const f32x4 g = *(const f32x4*)(gw_ + j * 256 + F.lane * 4), b = *(const f32x4*)(bw_ + j * 256 + F.lane * 4);
                v[j] = (v[j] - mean) * rstd * g + b; *(f32x4*)(xdst + (size_t)m * D + j * 256 + F.lane * 4) = v[j]; }
        }
        if (do_u) {
            ln_stats(v, mean, rstd);
            const int mr = (m < 4096) ? 0 : (m < ML ? 1 : 2);
            const float* mp = modl + (size_t)mr * 12288;
            bf16* up = WSP(bf16, O_U) + (size_t)m * D;
#pragma unroll
            for (int j = 0; j < 8; ++j) { const f32x4 sh = *(const f32x4*)(mp + sh_off + j * 256 + F.lane * 4), sc = *(const f32x4*)(mp + sc_off + j * 256 + F.lane * 4);
                const f32x4 o = (v[j] - mean) * rstd * (sc + 1.0f) + sh; u32x2 w; w.x = pk2(o[0], o[1]); w.y = pk2(o[2], o[3]);
                *(u32x2*)(up + j * 256 + F.lane * 4) = w; }
        }
    }
}

__device__ __forceinline__ void phase_rope_conv(const Frame& F_, int l, LAS unsigned char* lds) {
    Frame F = F_; F.lane = lane_id_fresh(); asm volatile("" : "+v"(F.lane), "+s"(F.wave)); F.tid = F.wave * 64 + F.lane;
    LAS f32x2* tab = (LAS f32x2*)lds;
    for (int i = F.tid; i < 2048; i += NTHR) { const int pos = i >> 5, ii = i & 31; const float inv = powf(10000.0f, -(float)ii * (1.0f / 32.0f)); const float ang = (float)pos * inv; tab[i] = (f32x2){cosf(ang), sinf(ang)}; }
    __syncthreads();
    const int gt = F.bid * NTHR + F.tid, NGT = F.G * NTHR;
    const bf16* P1 = WSP(const bf16, O_P1);
    for (int it0 = gt; it0 < ML * 128; it0 += 4 * NGT) {
        u32x4 av[4], bv[4];
#pragma unroll
        for (int q = 0; q < 4; ++q) { const int it = it0 + q * NGT; if (it < ML * 128) { const int ig = it & 3, half = (it >> 2) & 1, h = (it >> 3) & 7, qk = (it >> 6) & 1, tok = it >> 7;
            const bf16* src = P1 + (size_t)tok * NP1 + qk * 1024 + h * 128 + half * 64 + ig * 8; av[q] = __builtin_nontemporal_load((const u32x4*)src); bv[q] = __builtin_nontemporal_load((const u32x4*)(src + 32)); } }
#pragma unroll
        for (int q = 0; q < 4; ++q) { const int it = it0 + q * NGT; if (it < ML * 128) { const int ig = it & 3, half = (it >> 2) & 1, h = (it >> 3) & 7, qk = (it >> 6) & 1, tok = it >> 7;
            const int t = tok & 4095, pos = half ? (t & 63) : (t >> 6);
            const unsigned aw[4] = {av[q].x, av[q].y, av[q].z, av[q].w}, bw[4] = {bv[q].x, bv[q].y, bv[q].z, bv[q].w};
            float o1[8], o2[8];
#pragma unroll
            for (int j = 0; j < 8; ++j) { const float x1 = bf2f((aw[j >> 1] >> ((j & 1) * 16)) & 0xffffu), x2 = bf2f((bw[j >> 1] >> ((j & 1) * 16)) & 0xffffu);
                const f32x2 cs = tab[pos * 32 + ig * 8 + j]; o1[j] = x1 * cs.x - x2 * cs.y; o2[j] = x1 * cs.y + x2 * cs.x; }
            bf16* dst = qk ? WSP(bf16, O_KR) + ((size_t)h * MT + tok) * 128 + half * 64 + ig * 8 : WSP(bf16, O_QR) + (size_t)tok * 1024 + h * 128 + half * 64 + ig * 8;
            u32x4 w1, w2; w1.x = pk2(o1[0], o1[1]); w1.y = pk2(o1[2], o1[3]); w1.z = pk2(o1[4], o1[5]); w1.w = pk2(o1[6], o1[7]);
            w2.x = pk2(o2[0], o2[1]); w2.y = pk2(o2[2], o2[3]); w2.z = pk2(o2[4], o2[5]); w2.w = pk2(o2[6], o2[7]);
            *(u32x4*)dst = w1; *(u32x4*)(dst + 32) = w2; } }
    }
    for (int it = gt; it < 512 * 128; it += NGT) { const int c8 = it & 15, h = (it >> 4) & 7, tok = ML + (it >> 7);
        *(u32x4*)(WSP(bf16, O_KR) + ((size_t)h * MT + tok) * 128 + c8 * 8) = *(const u32x4*)(P1 + (size_t)tok * NP1 + 1024 + h * 128 + c8 * 8); }
    const float* cw = F.in[I_CONVW] + (size_t)l * 4 * 512; const float* cb = F.in[I_CONVB] + (size_t)l * 512;
    for (int it = gt; it < MT * 64; it += NGT) { const int c8 = it & 63, m = it >> 6;
        int pos, len; if (m < ML) { pos = m & 4095; len = 4096; } else { pos = (m - ML) & 255; len = 256; }
        float acc[8];
        { const f32x4 b0 = *(const f32x4*)(cb + c8 * 8), b1 = *(const f32x4*)(cb + c8 * 8 + 4);
#pragma unroll
          for (int j = 0; j < 4; ++j) { acc[j] = b0[j]; acc[4 + j] = b1[j]; } }
#pragma unroll
        for (int jj = 0; jj < 4; ++jj) { const int p = pos + jj - 2; if (p < 0 || p >= len) continue;
            const u32x4 xv = *(const u32x4*)(P1 + (size_t)(m + jj - 2) * NP1 + 2048 + c8 * 8); const unsigned xw[4] = {xv.x, xv.y, xv.z, xv.w};
            const f32x4 w0 = *(const f32x4*)(cw + jj * 512 + c8 * 8), w1 = *(const f32x4*)(cw + jj * 512 + c8 * 8 + 4);
#pragma unroll
            for (int j = 0; j < 8; ++j) { const float x = bf2f((xw[j >> 1] >> ((j & 1) * 16)) & 0xffffu); acc[j] += x * (j < 4 ? w0[j & 3] : w1[j & 3]); } }
        u32x4 o; o.x = pk2(acc[0], acc[1]); o.y = pk2(acc[2], acc[3]); o.z = pk2(acc[4], acc[5]); o.w = pk2(acc[6], acc[7]);
        *(u32x4*)(WSP(bf16, O_XC) + (size_t)m * 512 + c8 * 8) = o; }
}

constexpr float ATT_SCALE = 0.08838834764831845f, LOG2E = 1.4426950408889634f;
struct AttTile { bf16x8 k[8]; bf16x8 v[8]; };
__device__ __forceinline__ void att_offsets(unsigned (&koff)[2], unsigned (&voff)[2], int lane, int w) {
#pragma unroll
    for (int ii = 0; ii < 2; ++ii) { const int key = 8 * w + 4 * ii + (lane >> 4), sw = (((key >> 3) & 3) << 2) | (key & 3), chunk = (lane & 15) ^ sw; koff[ii] = (unsigned)(key * 128 + chunk * 8) * 2u;
        const int d = 16 * w + 8 * ii + (lane >> 3), cc = (lane & 7) ^ ((d >> 1) & 7); voff[ii] = (unsigned)(d * 64 + cc * 8) * 2u; }
}
__device__ __forceinline__ void att_issue(LAS unsigned char* buf, int w, const bf16* krow, const bf16* vrow, const unsigned (&koff)[2], const unsigned (&voff)[2]) {
#pragma unroll
    for (int ii = 0; ii < 2; ++ii) __builtin_amdgcn_global_load_lds((const unsigned*)((const char*)krow + koff[ii]), (LAS unsigned*)(buf + (2 * w + ii) * 1024), 16, 0, 0);
#pragma unroll
    for (int ii = 0; ii < 2; ++ii) __builtin_amdgcn_global_load_lds((const unsigned*)((const char*)vrow + voff[ii]), (LAS unsigned*)(buf + 16384 + (2 * w + ii) * 1024), 16, 0, 0);
}
__device__ __forceinline__ void att_fetch(AttTile& t, const LAS unsigned char* buf, int cb, int ql, int g, int km) {
#pragma unroll
    for (int s = 0; s < 4; ++s)
#pragma unroll
        for (int sub = 0; sub < 2; ++sub) { const int key = cb + km + 4 * sub, sw = (((key >> 3) & 3) << 2) | (key & 3);
            t.k[2 * s + sub] = *(const LAS bf16x8*)(buf + (key * 16 + ((4 * s + g) ^ sw)) * 16); }
#pragma unroll
    for (int dt = 0; dt < 8; ++dt) { const int d = 16 * dt + ql; t.v[dt] = *(const LAS bf16x8*)(buf + 16384 + (d * 8 + (((cb >> 3) + g) ^ ((d >> 1) & 7))) * 16); }
}
template <bool BAND>
__device__ __forceinline__ void att_compute(const AttTile& t, const bf16x8 (&q)[4], f32x4 (&o)[8], float& mrun, float& lsum, const LAS float* rpr, int kc0, int qc, int cs) {
    f32x4 s0 = (f32x4){0.f, 0.f, 0.f, 0.f}, s1 = s0;
#pragma unroll
    for (int s = 0; s < 4; ++s) { s0 = __builtin_amdgcn_mfma_f32_16x16x32_bf16(t.k[2 * s], q[s], s0, 0, 0, 0); s1 = __builtin_amdgcn_mfma_f32_16x16x32_bf16(t.k[2 * s + 1], q[s], s1, 0, 0, 0); }
    if (BAND) {
        float ba[4], bb[4];
#pragma unroll
        for (int i = 0; i < 4; ++i) { const int ka = kc0 + i, kb = ka + 4; ba[i] = rpr[min(max(ka - qc + 15, 0), 30)]; bb[i] = rpr[min(max(kb - qc + 15, 0), 30)]; }
#pragma unroll
        for (int i = 0; i < 4; ++i) { const int ka = kc0 + i, kb = ka + 4;
            const bool va = (ka >= cs) && (ka < cs + 16), vb = (kb >= cs) && (kb < cs + 16);
            s0[i] = va ? s0[i] * ATT_SCALE + ba[i] : -1e30f; s1[i] = vb ? s1[i] * ATT_SCALE + bb[i] : -1e30f; }
    } else { s0 = s0 * ATT_SCALE; s1 = s1 * ATT_SCALE; }
    float tmax = fmaxf(fmaxf(fmaxf(s0[0], s0[1]), fmaxf(s0[2], s0[3])), fmaxf(fmaxf(s1[0], s1[1]), fmaxf(s1[2], s1[3])));
    tmax = fmaxf(tmax, __shfl_xor(tmax, 16)); tmax = fmaxf(tmax, __shfl_xor(tmax, 32));
    const float mnew = fmaxf(mrun, tmax); const bool grew = __builtin_amdgcn_ballot_w64(mnew > mrun) != 0ull;
    const float corr = __builtin_amdgcn_exp2f((mrun - mnew) * LOG2E); mrun = mnew;
    const float ml = mnew * LOG2E;
    float p0[4], p1[4], ps = 0.f;
#pragma unroll
    for (int i = 0; i < 4; ++i) { p0[i] = (s0[i] > -1e29f) ? __builtin_amdgcn_exp2f(s0[i] * LOG2E - ml) : 0.f; p1[i] = (s1[i] > -1e29f) ? __builtin_amdgcn_exp2f(s1[i] * LOG2E - ml) : 0.f; ps += p0[i] + p1[i]; }
    lsum = lsum * corr + ps;
    if (grew) {
#pragma unroll
        for (int dt = 0; dt < 8; ++dt) o[dt] = o[dt] * corr;
    }
    union { u32x4 u; bf16x8 v; } pb; pb.u.x = pk2(p0[0], p0[1]); pb.u.y = pk2(p0[2], p0[3]); pb.u.z = pk2(p1[0], p1[1]); pb.u.w = pk2(p1[2], p1[3]);
#pragma unroll
    for (int dt = 0; dt < 8; ++dt) o[dt] = __builtin_amdgcn_mfma_f32_16x16x32_bf16(t.v[dt], pb.v, o[dt], 0, 0, 0);
}
__device__ __forceinline__ void phase_attention(const Frame& F_, int l, LAS unsigned char* lds) {
    Frame F = F_; F.lane = lane_id_fresh(); asm volatile("" : "+v"(F.lane), "+s"(F.wave)); F.tid = F.wave * 64 + F.lane;
    const int ql = F.lane & 15, g = F.lane >> 4, km = 8 * (ql >> 2) + (ql & 3);
    const int w = F.wave, wg = w & 3, rsel = w >> 2;
    const bf16* P1 = WSP(const bf16, O_P1); const bf16* QR = WSP(const bf16, O_QR); const bf16* KR = WSP(const bf16, O_KR); const bf16* VT = WSP(const bf16, O_VT);
    LAS float* tabB = (LAS float*)(lds + 131072 + 1024);
    for (int i = F.tid; i < 8 * 465; i += NTHR) tabB[i] = F.in[I_RPB][(size_t)l * 8 * 465 + i];
    __syncthreads();
    unsigned koff[2], voff[2]; att_offsets(koff, voff, F.lane, w);
    const int nbt = 512 + (l == 0 ? 32 : 0);
    for (int bi = 0; ; ++bi) {
        int bt = F.bid + bi * F.G;
        if (F.G == 256 && bi == 2) bt = (l == 0 && F.bid >= 32 && F.bid < 64) ? 512 + (F.bid - 32) : nbt;
        if (bt >= nbt) break;
        const bool lat = bt < 512;
        int b, h, tq, r = 0, r0 = 0, qc = 0;
        if (lat) { const int B = bt & 255, x = B & 7, slot = B >> 3; b = bt >> 8; h = x; r0 = 2 * slot; r = r0 + rsel; qc = 16 * wg + ql; tq = b * 4096 + r * 64 + qc; }
        else { const int q = bt - 512; b = q >> 4; h = (q >> 1) & 7; tq = ML + b * 256 + (q & 1) * 128 + w * 16 + ql; }
        const int cb = (wg == 0) ? 0 : (wg == 1 ? 8 : (wg == 2 ? 24 : 32));
        const int rs0 = min(max(r0 - 4, 0), 56), rs = min(max(r - 4, 0), 56), cs = min(max(qc - 8, 0), 48);
        const LAS float* rp = tabB + h * 465;
        const unsigned kband = (unsigned)((h * MT + b * 4096) * 128);
        const unsigned kctx = (unsigned)((h * MT + ML + b * 256) * 128);
        const unsigned vband = (unsigned)((b * 64) * 65536 + h * 8192);
        const unsigned vctx = (unsigned)((128 + b * 4) * 65536 + h * 8192);
        const int s0 = lat ? 0 : 9, nst = 13;
#define ATT_ISSUE(S) do { const int S_ = min((S), nst - 1); LAS unsigned char* bf_ = lds + ((S) & 3) * 32768; \
        if (S_ < 9) { const int R_ = min(rs0 + S_, 63); att_issue(bf_, w, KR + (kband + (unsigned)R_ * 8192u), VT + (vband + (unsigned)R_ * 65536u), koff, voff); } \
        else att_issue(bf_, w, KR + (kctx + (unsigned)(S_ - 9) * 8192u), VT + (vctx + (unsigned)(S_ - 9) * 65536u), koff, voff); } while (0)
        bf16x8 qr[4], qn[4];
#pragma unroll
        for (int s = 0; s < 4; ++s) { qn[s] = *(const bf16x8*)(P1 + (size_t)tq * NP1 + h * 128 + 8 * g + 32 * s); qr[s] = lat ? __builtin_nontemporal_load((const bf16x8*)(QR + (size_t)tq * 1024 + h * 128 + 8 * g + 32 * s)) : qn[s]; }
        __builtin_amdgcn_s_barrier();
        ATT_ISSUE(s0); ATT_ISSUE(s0 + 1); ATT_ISSUE(s0 + 2);
        f32x4 o[8];
#pragma unroll
        for (int dt = 0; dt < 8; ++dt) o[dt] = (f32x4){0.f, 0.f, 0.f, 0.f};
        float mrun = -1e30f, lsum = 0.f;
        for (int S = s0; S < nst; ++S) {
            asm volatile("s_waitcnt vmcnt(8)" ::: "memory");
            __builtin_amdgcn_s_barrier();
            asm volatile("" ::: "memory");
            ATT_ISSUE(S + 3);
            const LAS unsigned char* bf = lds + (S & 3) * 32768;
            AttTile t;
            if (S < 9) { const int R = rs0 + S;
                if (R >= rs && R < rs + 8) { att_fetch(t, bf, cb, ql, g, km); att_compute<true>(t, qr, o, mrun, lsum, rp + (R - r + 7) * 31, cb + 8 * g, qc, cs); } }
            else { att_fetch(t, bf, 0, ql, g, km); att_compute<false>(t, qn, o, mrun, lsum, rp, 0, 0, 0);
                   att_fetch(t, bf, 32, ql, g, km); att_compute<false>(t, qn, o, mrun, lsum, rp, 0, 0, 0); }
            asm volatile("s_waitcnt lgkmcnt(0)" ::: "memory");
        }
#undef ATT_ISSUE
        lsum += __shfl_xor(lsum, 16); lsum += __shfl_xor(lsum, 32);
        const float inv = 1.0f / lsum;
        bf16* op = WSP(bf16, O_MIX) + (size_t)tq * D + h * 128 + 4 * g;
#pragma unroll
        for (int dt = 0; dt < 8; ++dt) { u32x2 w2; w2.x = pk2(o[dt][0] * inv, o[dt][1] * inv); w2.y = pk2(o[dt][2] * inv, o[dt][3] * inv); *(u32x2*)(op + dt * 16) = w2; }
        asm volatile("s_waitcnt vmcnt(0)" ::: "memory");
    }
    __syncthreads();
}

__device__ __forceinline__ int chunk_tok0(int b, int ci) { return ci < 4 ? ML + b * 256 + ci * 64 : b * 4096 + (ci - 4) * 64; }
__device__ __forceinline__ void phase_scan1(const Frame& F_) {
    Frame F = F_; F.lane = lane_id_fresh(); asm volatile("" : "+v"(F.lane), "+s"(F.wave)); F.tid = F.wave * 64 + F.lane;
    const int gw = F.bid * NWAVES + F.wave, NGW = F.G * NWAVES;
    for (int task = gw; task < 2176; task += NGW) {
        const int ci = task % 68, cgp = (task / 68) & 7, dir = (task / 544) & 1, b = task / 1088;
        const int c = cgp * 64 + F.lane; const size_t base = ((size_t)dir * MT + chunk_tok0(b, ci)) * 512 + c;
        const unsigned* pa = WSP(const unsigned, O_AA) + base;
        float h = 0.f, Ls = 0.f;
        for (int i0 = 0; i0 < 64; i0 += 16) { unsigned wv[16];
#pragma unroll
            for (int k = 0; k < 16; ++k) { const int ii = dir ? 63 - (i0 + k) : (i0 + k); wv[k] = pa[(size_t)ii * 512]; }
#pragma unroll
            for (int k = 0; k < 16; ++k) { const float la = bf2f(wv[k] & 0xffffu); h = __builtin_amdgcn_exp2f(la * LOG2E) * h + bf2f(wv[k] >> 16); Ls += la; } }
        const size_t so = ((size_t)(b * 2 + dir) * 68 + ci) * 512 + c;
        WSP(float, O_SUMA)[so] = __builtin_amdgcn_exp2f(Ls * LOG2E); WSP(float, O_SUMB)[so] = h;
    }
}
__device__ __forceinline__ float gelu_tanh(float x) { const float t = 0.7978845608028654f * (x + 0.044715f * x * x * x); return 0.5f * x * (1.0f + tanhf(t)); }
__device__ __forceinline__ void phase_scan3(const Frame& F_, int l, LAS unsigned char* lds) {
    Frame F = F_; F.lane = lane_id_fresh(); asm volatile("" : "+v"(F.lane), "+s"(F.wave)); F.tid = F.wave * 64 + F.lane;
    const int gw = F.bid * NWAVES + F.wave, NGW = F.G * NWAVES;
    LAS float* hf = (LAS float*)(lds + F.wave * 16384);
    const float* SA = WSP(const float, O_SUMA); const float* SB = WSP(const float, O_SUMB);
    if (l == 0 && F.G == 256 && F.bid >= 136) convert_items(F, lds, (F.bid - 136) * NWAVES + F.wave, 960, CONV_IA + CONV_IB + CONV_IC1, CONV_PER);
    for (int task = gw; task < 1088; task += NGW) {
        const int ci = task % 68, cgp = (task / 68) & 7, b = task / 544;
        if (l == 1 && ci < 4) continue;
        const int c = cgp * 64 + F.lane; const int tok0 = chunk_tok0(b, ci);
        { float h = 0.f; const size_t sb = ((size_t)(b * 2 + 0) * 68) * 512 + c;
          for (int c0 = 0; c0 < ci; c0 += 8) { float ca[8], cbv[8];
#pragma unroll
              for (int k = 0; k < 8; ++k) { const int cj = min(c0 + k, ci - 1); ca[k] = SA[sb + (size_t)cj * 512]; cbv[k] = SB[sb + (size_t)cj * 512]; }
#pragma unroll
              for (int k = 0; k < 8; ++k) if (c0 + k < ci) h = ca[k] * h + cbv[k]; }
          const unsigned* pa = WSP(const unsigned, O_AA) + ((size_t)tok0) * 512 + c;
          for (int i0 = 0; i0 < 64; i0 += 16) { unsigned wv[16];
#pragma unroll
              for (int k = 0; k < 16; ++k) wv[k] = __builtin_nontemporal_load(&pa[(size_t)(i0 + k) * 512]);
#pragma unroll
              for (int k = 0; k < 16; ++k) { h = __builtin_amdgcn_exp2f(bf2f(wv[k] & 0xffffu) * LOG2E) * h + bf2f(wv[k] >> 16); hf[(i0 + k) * 64 + F.lane] = h; } } }
        { float h = 0.f; const size_t sb = ((size_t)(b * 2 + 1) * 68) * 512 + c;
          const int np = (ci < 4) ? 3 - ci : 4 + (67 - ci);
          for (int p0 = 0; p0 < np; p0 += 8) { float ca[8], cbv[8];
#pragma unroll
              for (int k = 0; k < 8; ++k) { const int p = min(p0 + k, np - 1); const int cj = (p < 4) ? 3 - p : 67 - (p - 4); ca[k] = SA[sb + (size_t)cj * 512]; cbv[k] = SB[sb + (size_t)cj * 512]; }
#pragma unroll
              for (int k = 0; k < 8; ++k) if (p0 + k < np) h = ca[k] * h + cbv[k]; }
          const unsigned* pa = WSP(const unsigned, O_AA) + ((size_t)MT + tok0) * 512 + c;
          const bf16* gp = WSP(const bf16, O_P1) + (size_t)tok0 * NP1 + 2560 + c; bf16* op = WSP(bf16, O_MIX) + (size_t)tok0 * D + 1024 + c;
          for (int i0 = 0; i0 < 64; i0 += 8) { unsigned wv[8]; float gv[8];
#pragma unroll
              for (int k = 0; k < 8; ++k) { const int ii = 63 - (i0 + k); wv[k] = __builtin_nontemporal_load(&pa[(size_t)ii * 512]); gv[k] = bf2f(__builtin_nontemporal_load(&gp[(size_t)ii * NP1])); }
#pragma unroll
              for (int k = 0; k < 8; ++k) { const int ii = 63 - (i0 + k); h = __builtin_amdgcn_exp2f(bf2f(wv[k] & 0xffffu) * LOG2E) * h + bf2f(wv[k] >> 16); const float y = hf[ii * 64 + F.lane] + h;
                  op[(size_t)ii * D] = (bf16)(pk2(y * gelu_tanh(gv[k]), 0.f) & 0xffffu); } } }
    }
    const int gt = F.bid * NTHR + F.tid, NGT = F.G * NTHR;
    const float* fb = F.in[I_FNOB] + (size_t)l * 512; const float* PT = WSP(const float, O_PART);
    for (int it = gt; it < 2 * 2048 * 128; it += NGT) { const int n4 = it & 127, k = (it >> 7) & 2047, b = it >> 18;
        const bf16* p = (const bf16*)PT + ((size_t)b * 2048 + k) * 512 + n4 * 4;
        f32x4 c = (f32x4){0.f, 0.f, 0.f, 0.f}, sn = c;
#pragma unroll
        for (int ks = 0; ks < 4; ++ks) { const u32x2 wc_ = __builtin_nontemporal_load((const u32x2*)(p + (size_t)ks * 4096 * 512)), ws_ = __builtin_nontemporal_load((const u32x2*)(p + (size_t)(4 + ks) * 4096 * 512));
            c[0] += bf2f(wc_.x & 0xffffu); c[1] += bf2f(wc_.x >> 16); c[2] += bf2f(wc_.y & 0xffffu); c[3] += bf2f(wc_.y >> 16);
            sn[0] += bf2f(ws_.x & 0xffffu); sn[1] += bf2f(ws_.x >> 16); sn[2] += bf2f(ws_.y & 0xffffu); sn[3] += bf2f(ws_.y >> 16); }
        const f32x4 bv = *(const f32x4*)(fb + n4 * 4);
        const f32x4 y1 = c + sn + bv, y2 = c - sn + bv;
        u32x2 w; w.x = pk2(y1[0], y1[1]); w.y = pk2(y1[2], y1[3]);
        *(u32x2*)(WSP(bf16, O_MIX) + ((size_t)b * 4096 + k) * D + 1536 + n4 * 4) = w;
        if (k > 0) { w.x = pk2(y2[0], y2[1]); w.y = pk2(y2[2], y2[3]); *(u32x2*)(WSP(bf16, O_MIX) + ((size_t)b * 4096 + 4096 - k) * D + 1536 + n4 * 4) = w; } }
    for (int task = gw; task < 1024; task += NGW) { const int n = task & 511, b = task >> 9;
        const bf16* ap = WSP(const bf16, O_ABT) + ((size_t)(b * 512 + n) * 2) * 4096 + F.lane * 64; float sacc = 0.f;
#pragma unroll
        for (int j = 0; j < 8; ++j) { const u32x4 v = *(const u32x4*)(ap + j * 8); const unsigned vw[4] = {v.x, v.y, v.z, v.w};
#pragma unroll
            for (int q = 0; q < 4; ++q) sacc += bf2f(vw[q] & 0xffffu) - bf2f(vw[q] >> 16); }
        sacc = wave_sum(sacc);
        if (F.lane == 0) WSP(bf16, O_MIX)[((size_t)b * 4096 + 2048) * D + 1536 + n] = (bf16)(pk2(sacc * 0.00138106793f + fb[n], 0.f) & 0xffffu); }
    if (l == 0) for (int it = gt; it < 512 * 128; it += NGT) { const int n4 = it & 127, r = it >> 7;
        const f32x4 v = *(const f32x4*)(PT + 16777216 + (size_t)r * 512 + n4 * 4) + *(const f32x4*)(fb + n4 * 4);
        u32x2 w; w.x = pk2(v[0], v[1]); w.y = pk2(v[2], v[3]);
        *(u32x2*)(WSP(bf16, O_MIX) + (size_t)(ML + r) * D + 1536 + n4 * 4) = w; }
}

__global__ void __launch_bounds__(NTHR, 2) mega_fwd(Params p) {
    extern __shared__ __attribute__((aligned(16))) unsigned char lds_raw[];
    LAS unsigned char* lds = (LAS unsigned char*)lds_raw;
    cg::grid_group grid = cg::this_grid();
    Frame F; F.in = p.in; F.ws = p.ws; F.out = p.out; F.tid = 0; F.lane = 0; F.wave = __builtin_amdgcn_readfirstlane(threadIdx.x >> 6); F.G = gridDim.x; F.bid = blockIdx.x;
#define modv WSP(const float, O_MODV)
    volatile LAS unsigned* xst = (volatile LAS unsigned*)(lds + 131072 + 64);
    if (threadIdx.x < 2) xst[threadIdx.x] = 0u;
    __syncthreads();
    (void)xcd_barrier_post(WSP(unsigned, O_BAR), xst);

#ifndef SK_PRO
    for (int _r = 0; _r < REP_PRO; ++_r) { phase_prologue(F, lds); __syncthreads(); }
#endif
    if (gridDim.y == 0x7fffffffu) grid.sync();
    GSYNC();
    phase_ln(F, 0, 0, MT, nullptr, nullptr, nullptr, true, modv, 0, 2048);
    __syncthreads();
#ifndef SK_FOLD
    { Sched S; S.init(F.ws, M_FOLD, 0, F.G, F.bid); EpiB E{F.ws, F.in, M_FOLD, 0}; pg8::gemm_phase<EpiB, Sched>(lds, F.wave, 512, 512, 8, S, E); }
#endif
    GSYNC();

    for (int l = 0; l < 2; ++l) {
#ifndef SK_INPROJ
        for (int _r = 0; _r < REP_INPROJ; ++_r) { __syncthreads(); Sched S; S.init(F.ws, M_INPROJ, l, F.G, F.bid); EpiB E{F.ws, F.in, M_INPROJ, l}; pg8::gemm_phase<EpiB, Sched>(lds, F.wave, 2048, 2048, 32, S, E); }
        if (l == 0 && F.G == 256 && F.bid >= 168) { Frame Fc = F; Fc.lane = lane_id_fresh(); asm volatile("" : "+v"(Fc.lane)); convert_items(Fc, lds, (F.bid - 168) * NWAVES + F.wave, 704, CONV_IA, CONV_IA + CONV_IB + CONV_IC1); }
#endif
        GSYNC();
#ifndef SK_ROPE
        for (int _r = 0; _r < REP_ELT; ++_r) { phase_rope_conv(F, l, lds); __syncthreads(); }
#endif
        GSYNC();
#ifndef SK_DFT
        for (int _r = 0; _r < REP_DFTG; ++_r) { __syncthreads(); Sched S; S.init(F.ws, M_DFT, l, F.G, F.bid); EpiF E{F.ws, F.in, M_DFT, l}; pg8::gemm_phase<EpiF, Sched>(lds, F.wave, 8192, 8192, 16, S, E); }
#endif
        __syncthreads();
#ifndef SK_GATES
        for (int _r = 0; _r < REP_DFTG; ++_r) { __syncthreads(); Sched S; S.init(F.ws, M_GATES, l, F.G, F.bid); EpiF E{F.ws, F.in, M_GATES, l}; pg8::gemm_phase<EpiF, Sched>(lds, F.wave, 512, 512, 2, S, E); }
        if (l == 0) { __syncthreads(); Sched S; S.init(F.ws, M_CDFT, l, F.G, F.bid); EpiF E{F.ws, F.in, M_CDFT, l}; pg8::gemm_phase<EpiF, Sched>(lds, F.wave, 512, 512, 8, S, E); }
#endif
#ifndef SK_ATT
        for (int _r = 0; _r < REP_ATT; ++_r) phase_attention(F, l, lds);
#endif
        GSYNC();
#ifndef SK_SCAN
        for (int _r = 0; _r < REP_ELT; ++_r) phase_scan1(F);
#endif
        GSYNC();
#ifndef SK_SCAN
        for (int _r = 0; _r < REP_ELT; ++_r) { phase_scan3(F, l, lds); __syncthreads(); }
#endif
        GSYNC();
#ifndef SK_WOUT
        for (int _r = 0; _r < REP_WOUT; ++_r) { __syncthreads(); Sched S; S.init(F.ws, M_WOUT, l, F.G, F.bid); EpiLN E{F.ws, F.in, F.out, M_WOUT, l, _r < REP_WOUT - 1}; pg8::gemm_phase<EpiLN, Sched>(lds, F.wave, 2048, 2048, 32, S, E); }
        if (l == 0) { __syncthreads(); Sched S; S.init(F.ws, M_WOUTC, l, F.G, F.bid); EpiF E{F.ws, F.in, M_WOUTC, l}; pg8::gemm_phase<EpiF, Sched>(lds, F.wave, 2048, 2048, 8, S, E); }
#endif
        GSYNC();
        if (l == 0) {
            for (int _r = 0; _r < REP_ELT; ++_r) phase_ln(F, 1, ML, MT, F.in[I_LN1G], F.in[I_LN1B], WSP(float, O_X), true, modv, 6144, 8192, 4, F.in[I_CTX], modv + 2 * 12288 + 4096, nullptr);
            GSYNC();
        }
#ifndef SK_FC1
        for (int _r = 0; _r < REP_FC1; ++_r) { __syncthreads(); Sched S; S.init(F.ws, M_FC1, l, F.G, F.bid); EpiB E{F.ws, F.in, M_FC1, l}; pg8::gemm_phase<EpiB, Sched>(lds, F.wave, 2048, 2048, 32, S, E); }
        if (l == 0 && F.G == 256 && F.bid >= 64) { Frame Fc = F; Fc.lane = lane_id_fresh(); asm volatile("" : "+v"(Fc.lane)); convert_items(Fc, lds, (F.bid - 64) * NWAVES + F.wave, 1536, CONV_PER, 2 * CONV_PER); }
#endif
        GSYNC();
#ifndef SK_FC2
        for (int _r = 0; _r < REP_FC2; ++_r) { __syncthreads(); Sched S; S.init(F.ws, M_FC2, l, F.G, F.bid); EpiLN E{F.ws, F.in, F.out, M_FC2, l, _r < REP_FC2 - 1}; pg8::gemm_phase<EpiLN, Sched>(lds, F.wave, 8192, 8192, 128, S, E); }
        if (l == 0) { __syncthreads(); Sched S; S.init(F.ws, M_FC2C, l, F.G, F.bid); EpiF E{F.ws, F.in, M_FC2C, l}; pg8::gemm_phase<EpiF, Sched>(lds, F.wave, 8192, 8192, 16, S, E); }
#endif
        if (l == 0) {
            GSYNC();
            phase_ln(F, 1, ML, MT, F.in[I_LN2G], F.in[I_LN2B], WSP(float, O_X), true, modv + (size_t)3 * 12288, 0, 2048, 8, WSP(const float, O_X) + (size_t)ML * D, modv + 2 * 12288 + 10240, F.in[I_BFC2]);
            GSYNC();
        }
    }
}

extern "C" void kernel_launch(void* const* d_in, const int* in_sizes, int n_in, void* d_out, int out_size, void* d_ws, size_t ws_size, hipStream_t stream) {
    static int grid = 0;
    if (grid == 0) {
        if (n_in != 26 || ws_size < O_END) { fprintf(stderr, "kernel_launch: unexpected n_in %d / ws %zu (need %zu)\n", n_in, ws_size, (size_t)O_END); grid = -1; return; }
        int dev = 0, cus = 0, per_cu = 0;
        hipGetDevice(&dev); hipDeviceGetAttribute(&cus, hipDeviceAttributeMultiprocessorCount, dev);
        hipFuncSetAttribute((const void*)mega_fwd, hipFuncAttributeMaxDynamicSharedMemorySize, LDS_BYTES);
        hipOccupancyMaxActiveBlocksPerMultiprocessor(&per_cu, (const void*)mega_fwd, NTHR, LDS_BYTES);
        if (per_cu < 1) { fprintf(stderr, "kernel_launch: occupancy query says %d blocks per CU\n", per_cu); per_cu = 1; }
        grid = cus;
        (void)hipGetLastError();
    }
    if (grid < 0) return;
    Params p{};
    for (int i = 0; i < 26; ++i) p.in[i] = (const float*)d_in[i];
    p.out = (float*)d_out; p.ws = (unsigned char*)d_ws;
    if (hipMemsetAsync((char*)d_ws + O_BAR, 0, MEMSET_BYTES, stream) != hipSuccess) { fprintf(stderr, "kernel_launch: memset failed\n"); return; }
    void* args[] = {&p};
    hipError_t e = hipLaunchCooperativeKernel((const void*)mega_fwd, dim3(grid), dim3(NTHR), args, LDS_BYTES, stream);
    if (e != hipSuccess) fprintf(stderr, "cooperative launch failed: %s (grid %d)\n", hipGetErrorString(e), grid);
}
```

```cpp
#include <hip/hip_runtime.h>
#include <hip/hip_cooperative_groups.h>
#include <cstdio>
#include <cstdint>
namespace cg = cooperative_groups;
#ifndef REP_PRO
#define REP_PRO 1
#endif
#ifndef REP_ATT
#define REP_ATT 1
#endif
#ifndef REP_ELT
#define REP_ELT 1
#endif
#ifndef REP_INPROJ
#define REP_INPROJ 1
#endif
#ifndef REP_FC1
#define REP_FC1 1
#endif
#ifndef REP_DFTG
#define REP_DFTG 1
#endif
#ifndef REP_PA
#define REP_PA 1
#endif
#ifndef REP_PB
#define REP_PB 1
#endif
#ifndef REP_PC
#define REP_PC 1
#endif
#ifndef REP_PD
#define REP_PD 1
#endif
#ifndef REP_WOUT
#define REP_WOUT 1
#endif
#ifndef REP_FC2
#define REP_FC2 1
#endif
#ifndef REP_SYNC
#define REP_SYNC 1
#endif
#define GSYNC() do { for (int _r = 0; _r < REP_SYNC; ++_r) { XcdBarrier xb_; xb_.bar = (unsigned*)(p.ws + O_BAR); xb_.x = xb_xcc_id(); xb_.st = (volatile LAS unsigned*)(lds + 131072 + 64); xcd_barrier(xb_); } } while (0)

#define LAS __attribute__((address_space(3)))
typedef unsigned short bf16;
typedef short bf16x8 __attribute__((ext_vector_type(8)));
typedef float f32x4 __attribute__((ext_vector_type(4)));
typedef float f32x2 __attribute__((ext_vector_type(2)));
typedef unsigned u32x4 __attribute__((ext_vector_type(4)));
typedef unsigned u32x2 __attribute__((ext_vector_type(2)));

constexpr int D = 2048, ML = 8192, MT = 8704, DFF = 8192, NP1 = 3072;
constexpr float LN_EPS = 1e-5f;
constexpr float ALPHA = 1.41421356237f;
constexpr int NWAVES = 8, NTHR = 512;
constexpr int LDS_BYTES = 147456;

constexpr size_t O_WIN = 0;
constexpr size_t O_WOUT = O_WIN + 41943040;
constexpr size_t O_W1 = O_WOUT + 16777216;
constexpr size_t O_W2 = O_W1 + 67108864;
constexpr size_t O_WG = O_W2 + 67108864;
constexpr size_t O_WF = O_WG + 4194304;
constexpr size_t O_WFOLD = O_WF + 4194304;
constexpr size_t O_DFT = O_WFOLD + 2097152;
constexpr size_t O_DFTC = O_DFT + 67108864;
constexpr size_t O_MODV = O_DFTC + 262144;
constexpr size_t O_X = O_MODV + 294912;
constexpr size_t O_Y = O_X + 71303168;
constexpr size_t O_U = O_Y + 71303168;
constexpr size_t O_MIX = O_U + 35651584;
constexpr size_t O_R = O_MIX + 35651584;
constexpr size_t O_P1 = O_R;
constexpr size_t O_VT = O_P1 + 53477376;
constexpr size_t O_ABT = O_VT + 17825792;
constexpr size_t O_ABTC = O_ABT + 16777216;
constexpr size_t O_QR = O_ABTC + 1048576;
constexpr size_t O_KR = O_QR + 16777216;
constexpr size_t O_XC = O_KR + 17825792;
constexpr size_t O_AA = O_XC + 8912896;
constexpr size_t O_UU = O_AA + 35651584;
constexpr size_t O_PART = O_UU + 35651584;
constexpr size_t O_SUMA = O_PART + 71303168;
constexpr size_t O_SUMB = O_SUMA + 557056;
constexpr size_t O_SPT = O_SUMB + 557056;
constexpr size_t O_CPART = O_SPT + 8192;
constexpr size_t O_BAR = O_CPART + 33554432;
constexpr size_t O_CNT = O_BAR + 16384;
constexpr size_t O_XB = O_CNT + 131072;
constexpr size_t O_END = O_XB + 2 * 524288;
constexpr size_t MEMSET_BYTES = 16384 + 131072;
constexpr size_t O_H = O_R;
static_assert(O_H + 142606336 <= O_END, "H overlay");

struct Params { const float* in[26]; float* out; unsigned char* ws; };
enum { I_X = 0, I_C, I_CTX, I_CCTX, I_WMOD, I_BMOD, I_WIN, I_RPB, I_CONVW, I_CONVB, I_WA, I_BA, I_WX, I_BX, I_LAM, I_FNOW, I_FNOB, I_WOUT, I_LN1G, I_LN1B, I_WFC1, I_BFC1, I_WFC2, I_BFC2, I_LN2G, I_LN2B };

__device__ __forceinline__ int lane_id_fresh() { unsigned m = ~0u; asm volatile("" : "+s"(m)); return (int)__builtin_amdgcn_mbcnt_hi(m, __builtin_amdgcn_mbcnt_lo(m, 0u)); }
__device__ __forceinline__ unsigned pk2(float lo, float hi) { unsigned r; asm volatile("v_cvt_pk_bf16_f32 %0, %1, %2" : "=v"(r) : "v"(lo), "v"(hi)); return r; }
__device__ __forceinline__ float bf2f(unsigned h) { return __uint_as_float(h << 16); }
__device__ __forceinline__ float sigmoidf_(float x) { return 1.0f / (1.0f + __expf(-x)); }
__device__ __forceinline__ float sigmoid_fast(float x) { return __builtin_amdgcn_rcpf(1.0f + __builtin_amdgcn_exp2f(-1.4426950408889634f * x)); }

namespace pg8 {
constexpr int BM = 256, BK = 64, HALF = 128, HTB = HALF * BK * 2, NXCD = 8, WGM = 8;
__device__ __forceinline__ int lds_byte(int r, int c) { const int st = (r >> 4) * 2 + (c >> 5), rr = r & 15, cc = c & 31, ob = rr * 64 + cc * 2; return st * 1024 + (ob ^ (((ob >> 9) & 1) << 5)); }
__device__ __forceinline__ void stage_rc(int b, int& R, int& C) { const int st = b / 1024, sb = b % 1024, swz = sb ^ (((sb >> 9) & 1) << 5); R = (st >> 1) * 16 + swz / 64; C = (st & 1) * 32 + (swz % 64) / 2; }
__device__ __forceinline__ int perm32(int rho) { const int n = rho >> 4, i = rho & 15; return 8 * (i >> 2) + 4 * n + (i & 3); }

struct Unit { const char* a; const char* b; int pm, pn, aux; };

__device__ __forceinline__ void tile_of(int L, int nM, int nN, int& pm, int& pn) {
    const int nwg = nM * nN; int wgid = L;
    { const int q = nwg / NXCD, r = nwg % NXCD, xcd = wgid % NXCD, off = wgid / NXCD; wgid = (xcd < r ? xcd * (q + 1) : r * (q + 1) + (xcd - r) * q) + off; }
    const int nig = WGM * nN, gid = wgid / nig, fm = gid * WGM, gsz = (nM - fm) < WGM ? (nM - fm) : WGM;
    pm = fm + ((wgid % nig) % gsz); pn = (wgid % nig) / gsz;
}

template <class Epi, class Sched>
__device__ __forceinline__ void gemm_phase(LAS unsigned char* lds, const int wave_, const int lda_, const int ldb_, const int nt_, const Sched& S, const Epi& E) {
    int lda = lda_, ldb = ldb_, nt = nt_; asm volatile("" : "+s"(lda), "+s"(ldb), "+s"(nt));
    int lane = lane_id_fresh(); int wid = wave_; asm volatile("" : "+v"(lane), "+s"(wid));
    const int tid = wid * 64 + lane, wr = wid >> 2, wc = wid & 3, fr = lane & 15, fq = lane >> 4;
    unsigned voffA[2], voffB[2];
#pragma unroll
    for (int i = 0; i < 2; ++i) { int R, C; stage_rc(tid * 16 + i * 8192, R, C); const int Rb = Epi::PERM ? ((R & ~31) + perm32(R & 31)) : R;
        voffA[i] = (unsigned)(R * lda + C) * 2u; voffB[i] = (unsigned)(Rb * ldb + C) * 2u; }
    const size_t kstep = (size_t)(BK * 2);
    const size_t hstepA = (size_t)HALF * lda * 2, hstepB = (size_t)HALF * ldb * 2;
    const unsigned ldsw = (unsigned)wid * 1024u;
    const int aoff = lds_byte(wr * 64 + fr, fq * 8), boff = lds_byte(wc * 32 + fr, fq * 8);
#define PG8_SA(b, h) (((b) * 2 + (h)) * HTB)
#define PG8_SB(b, h) ((4 + (b) * 2 + (h)) * HTB)
#define PG8_STAGE(bufoff, gbase, voff) do { _Pragma("unroll") for (int _i = 0; _i < 2; ++_i) \
        __builtin_amdgcn_global_load_lds((const unsigned*)((const char*)(gbase) + (voff)[_i]), (LAS unsigned*)(lds + (bufoff) + ldsw + _i * 8192), 16, 0, 0); } while (0)
#define PG8_LDA(dst, b, h) do { _Pragma("unroll") for (int m = 0; m < 4; ++m) _Pragma("unroll") for (int k = 0; k < 2; ++k) dst[m][k] = *(const LAS bf16x8*)(lds + PG8_SA(b, h) + aoff + m * 2048 + k * 1024); } while (0)
#define PG8_LDB(dst, b, h) do { _Pragma("unroll") for (int n = 0; n < 2; ++n) _Pragma("unroll") for (int k = 0; k < 2; ++k) dst[n][k] = *(const LAS bf16x8*)(lds + PG8_SB(b, h) + boff + n * 2048 + k * 1024); } while (0)
#define PG8_MMA(ai, bj, At, Bt) do { __builtin_amdgcn_s_setprio(1); _Pragma("unroll") for (int m = 0; m < 4; ++m) _Pragma("unroll") for (int n = 0; n < 2; ++n) _Pragma("unroll") for (int k = 0; k < 2; ++k) \
        acc[ai][bj][m][n] = __builtin_amdgcn_mfma_f32_16x16x32_bf16(Bt[n][k], At[m][k], acc[ai][bj][m][n], 0, 0, 0); __builtin_amdgcn_s_setprio(0); } while (0)
#define PG8_WAIT_V(n) asm volatile("s_waitcnt vmcnt(" #n ")" ::: "memory")
#define PG8_WAIT_L(n) asm volatile("s_waitcnt lgkmcnt(" #n ")" ::: "memory")
#define PG8_BAR __builtin_amdgcn_s_barrier()
#define PG8_SCHED __builtin_amdgcn_sched_barrier(0)
    Unit cur, nxt; int ui = 0;
    if (!S.next(0, cur)) return;
    f32x4 acc[2][2][4][2];
#pragma unroll
    for (int a = 0; a < 2; ++a)
#pragma unroll
        for (int b = 0; b < 2; ++b)
#pragma unroll
            for (int m = 0; m < 4; ++m)
#pragma unroll
                for (int n = 0; n < 2; ++n) acc[a][b][m][n] = (f32x4){0.f, 0.f, 0.f, 0.f};
    bf16x8 At[4][2], B0[2][2], B1[2][2];
    const char* cA = cur.a; const char* cB = cur.b;
    PG8_STAGE(PG8_SB(0, 0), cB, voffB); PG8_STAGE(PG8_SB(0, 1), cB + hstepB, voffB); PG8_STAGE(PG8_SA(0, 0), cA, voffA); PG8_STAGE(PG8_SA(0, 1), cA + hstepA, voffA);
    if (wr == 1) PG8_BAR;
    PG8_WAIT_V(2); PG8_BAR;
    PG8_STAGE(PG8_SB(1, 0), cB + kstep, voffB); PG8_STAGE(PG8_SA(1, 0), cA + kstep, voffA); PG8_STAGE(PG8_SB(1, 1), cB + hstepB + kstep, voffB);
    PG8_WAIT_V(6); PG8_BAR;
    for (;;) {
        const bool has_next = S.next(ui + 1, nxt);
        const char* nA = has_next ? nxt.a : cA; const char* nB = has_next ? nxt.b : cB;
        for (int t = 0; t < nt; t += 2) {
            const bool last = (t == nt - 2);
            const char* a1 = cA + (size_t)(t + 1) * kstep;
            const char* a2 = last ? nA : cA + (size_t)(t + 2) * kstep; const char* b2 = last ? nB : cB + (size_t)(t + 2) * kstep;
            const char* a3 = a2 + kstep; const char* b3 = b2 + kstep;
            PG8_LDB(B0, 0, 0); PG8_LDB(B1, 0, 1); PG8_SCHED; PG8_LDA(At, 0, 0); PG8_STAGE(PG8_SA(1, 1), a1 + hstepA, voffA);
            PG8_WAIT_V(8); PG8_WAIT_L(0); PG8_BAR; PG8_MMA(0, 0, At, B0); PG8_MMA(0, 1, At, B1); PG8_BAR; PG8_SCHED;
            PG8_LDA(At, 0, 1); PG8_STAGE(PG8_SB(0, 0), b2, voffB); PG8_STAGE(PG8_SB(0, 1), b2 + hstepB, voffB); PG8_STAGE(PG8_SA(0, 0), a2, voffA);
            PG8_WAIT_V(8); PG8_WAIT_L(0); PG8_BAR; PG8_MMA(1, 0, At, B0); PG8_MMA(1, 1, At, B1); PG8_BAR; PG8_SCHED;
            PG8_LDB(B0, 1, 0); PG8_LDB(B1, 1, 1); PG8_SCHED; PG8_LDA(At, 1, 0); PG8_STAGE(PG8_SA(0, 1), a2 + hstepA, voffA);
            PG8_WAIT_V(8); PG8_WAIT_L(0); PG8_BAR; PG8_MMA(0, 0, At, B0); PG8_MMA(0, 1, At, B1); PG8_BAR; PG8_SCHED;
            PG8_LDA(At, 1, 1); PG8_STAGE(PG8_SB(1, 0), b3, voffB); PG8_STAGE(PG8_SB(1, 1), b3 + hstepB, voffB); PG8_STAGE(PG8_SA(1, 0), a3, voffA);
            PG8_WAIT_V(8); PG8_WAIT_L(0); PG8_BAR; PG8_MMA(1, 0, At, B0); PG8_MMA(1, 1, At, B1); PG8_BAR; PG8_SCHED;
        }
        if (wr == 0) PG8_BAR;
        if constexpr (!Epi::AFTER_DRAIN) { int fr_ = fr, fq_ = fq; asm volatile("" : "+v"(fr_), "+v"(fq_)); E(acc, cur, wr, wc, fr_, fq_); }
        if (!has_next) break;
#pragma unroll
        for (int a = 0; a < 2; ++a)
#pragma unroll
            for (int b = 0; b < 2; ++b)
#pragma unroll
                for (int m = 0; m < 4; ++m)
#pragma unroll
                    for (int n = 0; n < 2; ++n) acc[a][b][m][n] = (f32x4){0.f, 0.f, 0.f, 0.f};
        cur = nxt; cA = nA; cB = nB; ++ui;
        if (wr == 1) PG8_BAR;
    }
    PG8_WAIT_V(0);
    PG8_BAR;
    if constexpr (Epi::AFTER_DRAIN) { int fr_ = fr, fq_ = fq; asm volatile("" : "+v"(fr_), "+v"(fq_)); E.fused(acc, cur, wr, wc, fr_, fq_, lds, wid, lane); }
#undef PG8_SA
#undef PG8_SB
#undef PG8_STAGE
#undef PG8_LDA
#undef PG8_LDB
#undef PG8_MMA
#undef PG8_WAIT_V
#undef PG8_WAIT_L
#undef PG8_BAR
#undef PG8_SCHED
}
}

#define XB_TMO      128
#define XB_XCNT(j)  (256  + 64 * (j))
#define XB_XSUB(j)  (1280 + 64 * (j))
#define XB_XGEN(j)  (2304 + 64 * (j))
#define XB_TOP      3328
#define XB_TOPGEN   3392
#define XCD_BAR_WORDS 3456
#define XB_SPIN_CAP (1u << 22)
__device__ __forceinline__ unsigned xb_ld(unsigned* p)              { return __hip_atomic_load(p, __ATOMIC_RELAXED, __HIP_MEMORY_SCOPE_AGENT); }
__device__ __forceinline__ unsigned xb_add(unsigned* p, unsigned v) { return __hip_atomic_fetch_add(p, v, __ATOMIC_RELAXED, __HIP_MEMORY_SCOPE_AGENT); }
__device__ __forceinline__ unsigned xb_xcc_id() { return (unsigned)__builtin_amdgcn_s_getreg((3 << 11) | 20) & 0xFu; }
#define XB_SPIN(cond, bar) do { unsigned _sp = 0; while (cond) { __builtin_amdgcn_s_sleep(1); \
    if ((++_sp & 255u) == 0u) { if (xb_ld(&(bar)[XB_TMO])) break; if (_sp > XB_SPIN_CAP) { atomicAdd(&(bar)[XB_TMO], 1u); break; } } } } while (0)
struct XcdBarrier { unsigned* bar; unsigned x; volatile LAS unsigned* st; };
__device__ __forceinline__ XcdBarrier xcd_barrier_post(unsigned* bar, volatile LAS unsigned* st) {
    XcdBarrier b; b.bar = bar; b.x = xb_xcc_id(); b.st = st;
    if (threadIdx.x == 0) (void)xb_add(&bar[XB_XCNT(b.x)], 1u);
    return b;
}
__device__ __forceinline__ void xcd_barrier_complete(unsigned* bar, unsigned x, unsigned& nloc, unsigned& nx) {
    const unsigned G = gridDim.x * gridDim.y * gridDim.z;
    unsigned sum, cnt, mine, sp = 0u;
    for (;;) {
        sum = 0u; cnt = 0u; mine = 0u;
#pragma unroll
        for (unsigned j = 0; j < 16; ++j) { const unsigned c = xb_ld(&bar[XB_XCNT(j)]); sum += c; cnt += (c > 0u) ? 1u : 0u; mine = (j == x) ? c : mine; }
        if (sum == G) break;
        __builtin_amdgcn_s_sleep(1);
        if ((++sp & 255u) == 0u) { if (xb_ld(&bar[XB_TMO])) break; if (sp > XB_SPIN_CAP) { atomicAdd(&bar[XB_TMO], 1u); break; } }
    }
    nloc = mine > 0u ? mine : 1u; nx = cnt > 0u ? cnt : 1u;
}
__device__ __forceinline__ void xcd_barrier(const XcdBarrier& b) {
    asm volatile("s_waitcnt vmcnt(0)" ::: "memory");
    __syncthreads();
    if (threadIdx.x == 0) {
        unsigned* bar = b.bar;
        __builtin_amdgcn_s_waitcnt(0);
        unsigned nloc = b.st[0], nx = b.st[1];
        if (nloc == 0u) { xcd_barrier_complete(bar, b.x, nloc, nx); b.st[0] = nloc; b.st[1] = nx; }
        const unsigned old = xb_add(&bar[XB_XSUB(b.x)], 1u);
        const unsigned gen = old / nloc;
        if (old + 1u == (gen + 1u) * nloc) {
            __builtin_amdgcn_fence(__ATOMIC_RELEASE, "agent");
            asm volatile("s_waitcnt vmcnt(0)" ::: "memory");
            const unsigned og = xb_add(&bar[XB_TOP], 1u);
            const unsigned tg = og / nx;
            if (og + 1u == (tg + 1u) * nx) xb_add(&bar[XB_TOPGEN], 1u);
            else XB_SPIN(xb_ld(&bar[XB_TOPGEN]) == tg, bar);
            __builtin_amdgcn_fence(__ATOMIC_ACQUIRE, "agent");
            xb_add(&bar[XB_XGEN(b.x)], 1u);
            asm volatile("s_waitcnt vmcnt(0)" ::: "memory");
        } else {
            XB_SPIN(xb_ld(&bar[XB_XGEN(b.x)]) == gen, bar);
            __builtin_amdgcn_fence(__ATOMIC_ACQUIRE, "agent");
            asm volatile("s_waitcnt vmcnt(0)" ::: "memory");
        }
    }
    __syncthreads();
}

struct Frame {
    const float* const* in;
    unsigned char* ws; float* out;
    int tid, lane, wave, G, bid;
};
#define WSP(T, off) ((T*)(F.ws + (off)))

enum { M_FOLD = 0, M_INPROJ, M_FC1, M_DFT, M_GATES, M_WOUT, M_FC2, M_WOUTC, M_FC2C, M_CDFT, M_DFT2 };

struct Sched {
    unsigned char* ws; int mode, l, G, c, total;
    __device__ __forceinline__ void init(unsigned char* ws_, int mode_, int l_, int G_, int c_) {
        ws = ws_; mode = mode_; l = l_; G = G_; c = c_;
        const int nM = (l == 0) ? 34 : 32;
        switch (mode) {
            case M_FOLD: total = 64; break;
            case M_INPROJ: total = 34 * 12 + 8 * 34; break;
            case M_FC1: total = nM * 32; break;
            case M_DFT: total = 256; break;
            case M_GATES: total = 272; break;
            case M_CDFT: total = 4; break;
            case M_DFT2: total = 32; break;
            case M_WOUT: total = 256; break;
            case M_FC2: total = 256; break;
            case M_WOUTC: total = 64; break;
            default: total = 128; break;
        }
    }
    __device__ __forceinline__ bool next(int i, pg8::Unit& u) const {
        int L = i * G + c;
        if (mode == M_CDFT && G == 256) L -= 16;
        if (mode == M_DFT2) L -= 16;
        if (mode == M_DFT && G == 256 && L < 16) return false;
        if (L < 0 || L >= total) return false;
        const int nM = (l == 0) ? 34 : 32;
        u.aux = 0;
        switch (mode) {
            case M_FOLD: { const int lw = L >> 5, r = L & 31; u.pm = r >> 3; u.pn = r & 7; u.aux = lw;
                u.a = (const char*)(ws + O_WFOLD) + ((size_t)lw * 1024 + u.pm * 256) * 512 * 2; u.b = (const char*)(ws + O_WF) + ((size_t)lw * 2048 + u.pn * 256) * 512 * 2; } break;
            case M_INPROJ: {
                if (L < 408) { pg8::tile_of(L, 34, 12, u.pm, u.pn); u.aux = 0;
                    u.a = (const char*)(ws + O_U) + (size_t)u.pm * 256 * 2048 * 2; u.b = (const char*)(ws + O_WIN) + ((size_t)l * 5120 + u.pn * 256) * 2048 * 2; }
                else { pg8::tile_of(L - 408, 8, 34, u.pm, u.pn); u.aux = 1;
                    u.a = (const char*)(ws + O_WIN) + ((size_t)l * 5120 + 3072 + u.pm * 256) * 2048 * 2; u.b = (const char*)(ws + O_U) + (size_t)u.pn * 256 * 2048 * 2; }
            } break;
            case M_FC1: { pg8::tile_of(L, nM, 32, u.pm, u.pn);
                u.a = (const char*)(ws + O_U) + (size_t)u.pm * 256 * 2048 * 2; u.b = (const char*)(ws + O_W1) + ((size_t)l * 8192 + u.pn * 256) * 2048 * 2; } break;
            case M_DFT: { const int ks = L >> 5, r = L & 31, b = r >> 4, mt = (r & 15) >> 1, pn = r & 1; u.pm = b * 8 + mt; u.pn = pn; u.aux = ks;
                u.a = (const char*)(ws + O_DFT) + ((size_t)mt * 256 * 8192 + ks * 1024) * 2; u.b = (const char*)(ws + O_ABT) + ((size_t)(b * 512 + pn * 256) * 8192 + ks * 1024) * 2; } break;
            case M_GATES: { u.pm = L >> 3; u.pn = L & 7; u.aux = 0; const int blk = u.pn & 3;
                    u.a = (const char*)(ws + O_XC) + ((size_t)u.pm * 256 * 512 + blk * 128) * 2; u.b = (const char*)(ws + O_WG) + (((size_t)l * 2048 + u.pn * 256) * 512 + blk * 128) * 2; } break;
            case M_DFT2: { const int t = L >> 1, half = L & 1, mt = t >> 1, pn = t & 1; u.pm = mt; u.pn = pn; u.aux = half ? 8 : 0;
                    u.a = (const char*)(ws + O_DFT) + ((size_t)mt * 256 * 8192 + half * 512) * 2; u.b = (const char*)(ws + O_ABT) + ((size_t)(pn * 256) * 8192 + half * 512) * 2; } break;
            case M_CDFT: { const int b = L >> 1, pn = L & 1; u.pm = 32 + b; u.pn = pn; u.aux = 1;
                    u.a = (const char*)(ws + O_DFTC); u.b = (const char*)(ws + O_ABTC) + (size_t)(b * 512 + pn * 256) * 512 * 2; } break;
            case M_WOUT: { pg8::tile_of(L, 32, 8, u.pm, u.pn);
                u.a = (const char*)(ws + O_MIX) + (size_t)u.pm * 256 * 2048 * 2; u.b = (const char*)(ws + O_WOUT) + ((size_t)l * 2048 + u.pn * 256) * 2048 * 2; } break;
            case M_FC2: { pg8::tile_of(L, 32, 8, u.pm, u.pn);
                u.a = (const char*)(ws + O_H) + (size_t)u.pm * 256 * 8192 * 2; u.b = (const char*)(ws + O_W2) + ((size_t)l * 2048 + u.pn * 256) * 8192 * 2; } break;
            case M_WOUTC: { const int ks = L >> 4, r = L & 15; u.pm = 32 + (r >> 3); u.pn = r & 7; u.aux = ks;
                u.a = (const char*)(ws + O_MIX) + ((size_t)u.pm * 256 * 2048 + ks * 512) * 2; u.b = (const char*)(ws + O_WOUT) + (((size_t)l * 2048 + u.pn * 256) * 2048 + ks * 512) * 2; } break;
            default: { const int ks = L >> 4, r = L & 15; u.pm = 32 + (r >> 3); u.pn = r & 7; u.aux = ks;
                u.a = (const char*)(ws + O_H) + ((size_t)u.pm * 256 * 8192 + ks * 1024) * 2; u.b = (const char*)(ws + O_W2) + (((size_t)l * 2048 + u.pn * 256) * 8192 + ks * 1024) * 2; } break;
        }
        return true;
    }
};

__device__ __forceinline__ float bperm_f(int byteidx, float v) { return __int_as_float(__builtin_amdgcn_ds_bpermute(byteidx, __float_as_int(v))); }
__device__ __forceinline__ void xpose_f32(const f32x4& v0, const f32x4& v1, f32x4& oA, f32x4& oB, int lane) {
    const int srcA = ((lane >> 3) + 16 * (lane & 3)) * 4, srcB = srcA + 32; const bool hi = (lane >> 2) & 1;
#pragma unroll
    for (int j = 0; j < 4; ++j) { const float a0 = bperm_f(srcA, v0[j]), a1 = bperm_f(srcA, v1[j]), b0 = bperm_f(srcB, v0[j]), b1 = bperm_f(srcB, v1[j]); oA[j] = hi ? a1 : a0; oB[j] = hi ? b1 : b0; }
}
__device__ __forceinline__ u32x4 xpose_b16(const u32x4& w, int lane) {
    const int src = ((lane >> 2) + 16 * (lane & 3)) * 4; u32x4 o;
    o.x = (unsigned)__builtin_amdgcn_ds_bpermute(src, (int)w.x); o.y = (unsigned)__builtin_amdgcn_ds_bpermute(src, (int)w.y); o.z = (unsigned)__builtin_amdgcn_ds_bpermute(src, (int)w.z); o.w = (unsigned)__builtin_amdgcn_ds_bpermute(src, (int)w.w);
    return o;
}

struct EpiB {
    static constexpr bool PERM = true, AFTER_DRAIN = false;
    unsigned char* ws; const float* const* in; int mode, l;
    __device__ __forceinline__ void operator()(const f32x4 (&acc)[2][2][4][2], const pg8::Unit& u, int wr, int wc, int fr, int fq) const {
        bf16* base; size_t ld; const float* bias = nullptr; bool vtb = false;
        if (mode == M_FOLD) { base = (bf16*)(ws + O_WIN) + ((size_t)u.aux * 5120 + 4096 + u.pm * 256) * 2048 + u.pn * 256; ld = 2048; }
        else if (mode == M_FC1) { base = (bf16*)(ws + O_H) + (size_t)u.pm * 256 * 8192 + u.pn * 256; ld = 8192; bias = in[I_BFC1] + (size_t)l * 8192 + u.pn * 256; }
        else {
            if (u.aux == 0) { base = (bf16*)(ws + O_P1) + (size_t)u.pm * 256 * NP1 + u.pn * 256; ld = NP1; }
            else if (u.pm < 4) { base = (bf16*)(ws + O_VT) + (size_t)(u.pn * 4) * 65536 + (size_t)u.pm * 256 * 64; ld = 64; vtb = true; }
            else { const int q = u.pm - 4, part = q >> 1, nb = (q & 1) * 256;
                if (u.pn < 32) { const int bb = u.pn >> 4, t0 = (u.pn & 15) * 256; base = (bf16*)(ws + O_ABT) + ((size_t)(bb * 512 + nb) * 2 + part) * 4096 + t0; ld = 8192; }
                else { const int bb = u.pn - 32; base = (bf16*)(ws + O_ABTC) + ((size_t)(bb * 512 + nb) * 2 + part) * 256; ld = 512; } }
        }
        const int lane = fr + 16 * fq;
        const int row0 = wr * 64 + (lane >> 2), col0 = wc * 32 + 8 * fq, scol0 = wc * 32 + 8 * (lane & 3);
        f32x4 bv[2][2];
#pragma unroll
        for (int bj = 0; bj < 2; ++bj)
#pragma unroll
            for (int n = 0; n < 2; ++n) bv[bj][n] = bias ? *(const f32x4*)(bias + col0 + bj * 128 + 4 * n) : (f32x4){0.f, 0.f, 0.f, 0.f};
#pragma unroll
        for (int ai = 0; ai < 2; ++ai)
#pragma unroll
            for (int m = 0; m < 4; ++m) { bf16* rowp = base + (size_t)(row0 + ai * 128 + m * 16) * ld + (vtb ? (size_t)(scol0 >> 6) * 65536 + (scol0 & 63) : (size_t)scol0);
                const size_t bjs = vtb ? 131072 : 128;
#pragma unroll
                for (int bj = 0; bj < 2; ++bj) { f32x4 v0 = acc[ai][bj][m][0] + bv[bj][0], v1 = acc[ai][bj][m][1] + bv[bj][1];
                    if (mode == M_FC1) {
#pragma unroll
                        for (int j = 0; j < 4; ++j) { const float a = fmaxf(v0[j], 0.f), b = fmaxf(v1[j], 0.f); v0[j] = a * a; v1[j] = b * b; } }
                    u32x4 w; w.x = pk2(v0[0], v0[1]); w.y = pk2(v0[2], v0[3]); w.z = pk2(v1[0], v1[1]); w.w = pk2(v1[2], v1[3]);
                    *(u32x4*)(rowp + bj * bjs) = xpose_b16(w, lane); } }
    }
};

struct EpiF {
    static constexpr bool PERM = false, AFTER_DRAIN = false;
    unsigned char* ws; const float* const* in; int mode, l;
    __device__ __forceinline__ void operator()(const f32x4 (&acc)[2][2][4][2], const pg8::Unit& u, int wr, int wc, int fr, int fq) const {
        const int lane = fr + 16 * fq;
        const int row0 = wr * 64 + fr, col0 = wc * 32 + 4 * fq, srow0 = wr * 64 + (lane >> 3), scol0 = wc * 32 + 4 * (lane & 7);
        if (mode == M_DFT || mode == M_DFT2 || mode == M_WOUTC || mode == M_FC2C || mode == M_CDFT) {
            const size_t ldp = (mode == M_WOUTC || mode == M_FC2C) ? 2048 : 512;
            float* base = (mode == M_DFT || mode == M_DFT2) ? (float*)(ws + O_PART) + ((size_t)u.aux * 4096 + u.pm * 256) * 512 + u.pn * 256
                        : (mode == M_CDFT) ? (float*)(ws + O_PART) + 16777216 + ((size_t)(u.pm - 32) * 256) * 512 + u.pn * 256
                        : (float*)(ws + O_CPART) + ((size_t)u.aux * 512 + (u.pm - 32) * 256) * 2048 + u.pn * 256;
#pragma unroll
            for (int ai = 0; ai < 2; ++ai)
#pragma unroll
                for (int m = 0; m < 4; ++m) { float* rowp = base + (size_t)(srow0 + ai * 128 + m * 16) * ldp + scol0;
#pragma unroll
                    for (int bj = 0; bj < 2; ++bj) { f32x4 oA, oB; xpose_f32(acc[ai][bj][m][0], acc[ai][bj][m][1], oA, oB, lane);
                        if (mode == M_DFT || mode == M_DFT2) { bf16* hp = (bf16*)(ws + O_PART) + (rowp - (float*)(ws + O_PART));
                            u32x2 wA, wB; wA.x = pk2(oA[0], oA[1]); wA.y = pk2(oA[2], oA[3]); wB.x = pk2(oB[0], oB[1]); wB.y = pk2(oB[2], oB[3]);
                            *(u32x2*)(hp + bj * 128) = wA; *(u32x2*)(hp + 8 * ldp + bj * 128) = wB; }
                        else { *(f32x4*)(rowp + bj * 128) = oA; *(f32x4*)(rowp + 8 * ldp + bj * 128) = oB; } } }
        } else if (mode == M_GATES) {
            const int d = u.pn >> 2, blk = u.pn & 3;
            const float* ba = in[I_BA] + ((size_t)l * 2 + d) * 512; const float* bx = in[I_BX] + ((size_t)l * 2 + d) * 512; const float* lam = (const float*)(ws + O_SPT) + ((size_t)l * 2 + d) * 512;
            const bf16* xc = (const bf16*)(ws + O_XC);
            unsigned* Ao = (unsigned*)(ws + O_AA) + (size_t)d * MT * 512;
            f32x4 bav[2], bxv[2], sp[2];
#pragma unroll
            for (int n = 0; n < 2; ++n) { const int ch = blk * 128 + col0 + 16 * n; bav[n] = *(const f32x4*)(ba + ch); bxv[n] = *(const f32x4*)(bx + ch); sp[n] = *(const f32x4*)(lam + ch); }
            const int sch = blk * 128 + scol0;
#pragma unroll
            for (int ai = 0; ai < 2; ++ai)
#pragma unroll
                for (int m = 0; m < 4; ++m) {
                    const size_t tok = (size_t)u.pm * 256 + srow0 + ai * 128 + m * 16;
                    const u32x2 xa = __builtin_nontemporal_load((const u32x2*)(xc + tok * 512 + sch)), xb = __builtin_nontemporal_load((const u32x2*)(xc + (tok + 8) * 512 + sch));
                    f32x4 av[2], uv[2];
#pragma unroll
                    for (int n = 0; n < 2; ++n)
#pragma unroll
                        for (int j = 0; j < 4; ++j) {
                            const float r = sigmoid_fast(acc[ai][0][m][n][j] + bav[n][j]);
                            const float ig = sigmoid_fast(acc[ai][1][m][n][j] + bxv[n][j]);
                            const float la = sp[n][j] * r;
                            av[n][j] = la;
                            const float aa = __builtin_amdgcn_exp2f(1.4426950408889634f * la);
                            const float x2 = 2.0f * la;
                            const float ser = -x2 * (1.0f + x2 * (0.5f + x2 * (0.16666667f + x2 * (0.041666668f + x2 * (0.0083333338f + x2 * 0.0013888889f)))));
                            const float om = (x2 > -0.35f) ? ser : 1.0f - aa * aa;
                            uv[n][j] = __builtin_amdgcn_sqrtf(fmaxf(om, 0.f)) * ig;
                        }
                    f32x4 aA, aB, uA, uB; xpose_f32(av[0], av[1], aA, aB, lane); xpose_f32(uv[0], uv[1], uA, uB, lane);
                    uA[0] *= bf2f(xa.x & 0xffffu); uA[1] *= bf2f(xa.x >> 16); uA[2] *= bf2f(xa.y & 0xffffu); uA[3] *= bf2f(xa.y >> 16);
                    uB[0] *= bf2f(xb.x & 0xffffu); uB[1] *= bf2f(xb.x >> 16); uB[2] *= bf2f(xb.y & 0xffffu); uB[3] *= bf2f(xb.y >> 16);
                    u32x4 wA, wB; wA.x = pk2(aA[0], uA[0]); wA.y = pk2(aA[1], uA[1]); wA.z = pk2(aA[2], uA[2]); wA.w = pk2(aA[3], uA[3]);
                    wB.x = pk2(aB[0], uB[0]); wB.y = pk2(aB[1], uB[1]); wB.z = pk2(aB[2], uB[2]); wB.w = pk2(aB[3], uB[3]);
                    *(u32x4*)(Ao + tok * 512 + sch) = wA; *(u32x4*)(Ao + (tok + 8) * 512 + sch) = wB;
                    asm volatile("" ::: "memory");
                }
        } else {
            const int mr = (u.pm < 16) ? 0 : (u.pm < 32 ? 1 : 2);
            const float* gp = (const float*)(ws + O_MODV) + ((size_t)l * 3 + mr) * 12288 + (mode == M_WOUT ? 4096 : 10240) + u.pn * 256;
            const float* bias = (mode == M_FC2) ? in[I_BFC2] + (size_t)l * 2048 + u.pn * 256 : nullptr;
            const float* xs;
            if (mode == M_WOUT && l == 0) xs = (u.pm < 32) ? in[I_X] + (size_t)u.pm * 256 * D : in[I_CTX] + (size_t)(u.pm - 32) * 256 * D;
            else xs = (const float*)(ws + O_X) + (size_t)u.pm * 256 * D;
            xs += u.pn * 256;
            float* yo = (float*)(ws + O_Y) + (size_t)u.pm * 256 * D + u.pn * 256;
            f32x4 gv[2][2], bv[2][2];
#pragma unroll
            for (int bj = 0; bj < 2; ++bj)
#pragma unroll
                for (int n = 0; n < 2; ++n) { gv[bj][n] = *(const f32x4*)(gp + col0 + bj * 128 + n * 16); bv[bj][n] = bias ? *(const f32x4*)(bias + col0 + bj * 128 + n * 16) : (f32x4){0.f, 0.f, 0.f, 0.f}; }
#pragma unroll
            for (int ai = 0; ai < 2; ++ai)
#pragma unroll
                for (int m = 0; m < 4; ++m) { const size_t off = (size_t)(srow0 + ai * 128 + m * 16) * D + scol0;
#pragma unroll
                    for (int bj = 0; bj < 2; ++bj) { f32x4 tA, tB; xpose_f32(gv[bj][0] * (acc[ai][bj][m][0] + bv[bj][0]), gv[bj][1] * (acc[ai][bj][m][1] + bv[bj][1]), tA, tB, lane);
                        const f32x4 xA = *(const f32x4*)(xs + off + bj * 128), xB = *(const f32x4*)(xs + off + 8 * D + bj * 128);
                        *(f32x4*)(yo + off + bj * 128) = xA * ALPHA + tA; *(f32x4*)(yo + off + 8 * D + bj * 128) = xB * ALPHA + tB; }
                    asm volatile("" ::: "memory"); }
        }
    }
};

struct PanelStats {
    unsigned long long* xbuf; unsigned* cnt;
    __device__ __forceinline__ void run(const f32x4 (&v)[2][2][4][2], const pg8::Unit& u, int wr, int wc, LAS unsigned char* lds, int wid, int lane) const {
        LAS f32x2* P = (LAS f32x2*)lds;
        LAS f32x2* S = (LAS f32x2*)(lds + 8192);
        const int rl = lane >> 3, cl = lane & 7;
#pragma unroll
        for (int ai = 0; ai < 2; ++ai)
#pragma unroll
            for (int m = 0; m < 4; ++m)
#pragma unroll
                for (int h = 0; h < 2; ++h) {
                    const f32x4 x0 = v[ai][0][m][h], x1 = v[ai][1][m][h];
                    float s = ((x0[0] + x0[1]) + (x0[2] + x0[3])) + ((x1[0] + x1[1]) + (x1[2] + x1[3]));
                    s += __shfl_xor(s, 1); s += __shfl_xor(s, 2); s += __shfl_xor(s, 4);
                    const float mw = s * (1.0f / 64.0f);
                    const f32x4 d0 = x0 - mw, d1 = x1 - mw;
                    float q = ((d0[0] * d0[0] + d0[1] * d0[1]) + (d0[2] * d0[2] + d0[3] * d0[3])) + ((d1[0] * d1[0] + d1[1] * d1[1]) + (d1[2] * d1[2] + d1[3] * d1[3]));
                    q += __shfl_xor(q, 1); q += __shfl_xor(q, 2); q += __shfl_xor(q, 4);
                    if (cl == 0) P[(ai * 128 + wr * 64 + m * 16 + h * 8 + rl) * 4 + wc] = (f32x2){mw, q};
                }
        asm volatile("s_waitcnt lgkmcnt(0)" ::: "memory"); __builtin_amdgcn_s_barrier(); asm volatile("" ::: "memory");
        const int row = wid * 32 + (lane & 31);
        if (lane < 32) {
            const f32x2 a = P[row * 4 + 0], b = P[row * 4 + 1], c = P[row * 4 + 2], d = P[row * 4 + 3];
            const float mt = (a.x + b.x + c.x + d.x) * 0.25f;
            const float da = a.x - mt, db = b.x - mt, dc = c.x - mt, dd = d.x - mt;
            const float m2 = (a.y + b.y) + (c.y + d.y) + 64.0f * ((da * da + db * db) + (dc * dc + dd * dd));
            __hip_atomic_store(xbuf + ((size_t)(u.pm * 256 + row) * 8 + u.pn), ((unsigned long long)__float_as_uint(m2) << 32) | __float_as_uint(mt), __ATOMIC_RELAXED, __HIP_MEMORY_SCOPE_AGENT);
        }
        asm volatile("s_waitcnt vmcnt(0)" ::: "memory");
        if (lane == 0) __hip_atomic_fetch_add(cnt + 64 * u.pm, 1u, __ATOMIC_RELAXED, __HIP_MEMORY_SCOPE_AGENT);
        if (wid == 0) {
            unsigned sp = 0;
            while ((unsigned)__builtin_amdgcn_readfirstlane(__hip_atomic_load(cnt + 64 * u.pm, __ATOMIC_RELAXED, __HIP_MEMORY_SCOPE_AGENT)) < 64u) { __builtin_amdgcn_s_sleep(2); if (++sp > (1u << 22)) break; }
            __builtin_amdgcn_fence(__ATOMIC_ACQUIRE, "agent");
        }
        asm volatile("s_waitcnt vmcnt(0) lgkmcnt(0)" ::: "memory"); __builtin_amdgcn_s_barrier(); asm volatile("" ::: "memory");
        if (lane < 32) {
            const unsigned long long* slot = xbuf + (size_t)(u.pm * 256 + row) * 8; float mt[8], m2[8]; float ms = 0.f;
#pragma unroll
            for (int t = 0; t < 8; ++t) { const unsigned long long w = __hip_atomic_load(slot + t, __ATOMIC_RELAXED, __HIP_MEMORY_SCOPE_AGENT); mt[t] = __uint_as_float((unsigned)w); m2[t] = __uint_as_float((unsigned)(w >> 32)); ms += mt[t]; }
            const float mean = ms * 0.125f; float q = 0.f;
#pragma unroll
            for (int t = 0; t < 8; ++t) { const float dm = mt[t] - mean; q += m2[t] + 256.0f * dm * dm; }
            S[row] = (f32x2){mean, 1.0f / sqrtf(q * (1.0f / 2048.0f) + LN_EPS)};
        }
        asm volatile("s_waitcnt lgkmcnt(0)" ::: "memory"); __builtin_amdgcn_s_barrier(); asm volatile("" ::: "memory");
    }
};
struct EpiLN {
    static constexpr bool PERM = false, AFTER_DRAIN = true;
    unsigned char* ws; const float* const* in; float* out; int mode, l; int dry;
    __device__ __forceinline__ void operator()(const f32x4 (&)[2][2][4][2], const pg8::Unit&, int, int, int, int) const {}
    __device__ __forceinline__ void fused(f32x4 (&acc)[2][2][4][2], const pg8::Unit& u, int wr, int wc, int fr, int fq, LAS unsigned char* lds, int wid, int lane) const {
        const int col0 = wc * 32 + 4 * fq;
        const int rl = lane >> 3, scol = wc * 32 + 4 * (lane & 7);
        const int mr = (u.pm < 16) ? 0 : 1;
        const float* modl = (const float*)(ws + O_MODV) + ((size_t)l * 3 + mr) * 12288;
        const float* gp = modl + (mode == M_WOUT ? 4096 : 10240) + u.pn * 256;
        const float* bias = (mode == M_FC2) ? in[I_BFC2] + (size_t)l * 2048 + u.pn * 256 : nullptr;
        const float* xs = (mode == M_WOUT && l == 0) ? in[I_X] + (size_t)u.pm * 256 * D : (const float*)(ws + O_X) + (size_t)u.pm * 256 * D;
        xs += u.pn * 256;
        const LAS f32x2* S = (const LAS f32x2*)(lds + 8192);
#pragma unroll
        for (int ai = 0; ai < 2; ++ai)
#pragma unroll
            for (int bj = 0; bj < 2; ++bj) {
                int rw0 = wr * 64 + ai * 128 + rl, sc0 = scol + bj * 128; asm volatile("" : "+v"(rw0), "+v"(sc0));
                f32x4 xv[4][2];
#pragma unroll
                for (int m = 0; m < 4; ++m)
#pragma unroll
                    for (int h = 0; h < 2; ++h) xv[m][h] = __builtin_nontemporal_load((const f32x4*)(xs + (size_t)(rw0 + m * 16 + 8 * h) * D + sc0));
                const f32x4 g0 = *(const f32x4*)(gp + col0 + bj * 128), g1 = *(const f32x4*)(gp + col0 + bj * 128 + 16);
                const f32x4 b0 = bias ? *(const f32x4*)(bias + col0 + bj * 128) : (f32x4){0.f, 0.f, 0.f, 0.f}, b1 = bias ? *(const f32x4*)(bias + col0 + bj * 128 + 16) : (f32x4){0.f, 0.f, 0.f, 0.f};
#pragma unroll
                for (int m = 0; m < 4; ++m) { f32x4 tA, tB; xpose_f32(g0 * (acc[ai][bj][m][0] + b0), g1 * (acc[ai][bj][m][1] + b1), tA, tB, lane);
                    acc[ai][bj][m][0] = xv[m][0] * ALPHA + tA; acc[ai][bj][m][1] = xv[m][1] * ALPHA + tB; }
                asm volatile("" : "+v"(acc[ai][bj][0][0]), "+v"(acc[ai][bj][0][1]), "+v"(acc[ai][bj][1][0]), "+v"(acc[ai][bj][1][1]), "+v"(acc[ai][bj][2][0]), "+v"(acc[ai][bj][2][1]), "+v"(acc[ai][bj][3][0]), "+v"(acc[ai][bj][3][1]) :: "memory");
            }
        const int bank = l * 4 + (mode == M_WOUT ? 0 : 2) + (dry ? 8 : 0);
        PanelStats st1{(unsigned long long*)(ws + O_XB), (unsigned*)(ws + O_CNT) + (size_t)bank * 2048};
        const float* gam = (mode == M_WOUT ? in[I_LN1G] : in[I_LN2G]) + (size_t)l * D + u.pn * 256; const float* bet = (mode == M_WOUT ? in[I_LN1B] : in[I_LN2B]) + (size_t)l * D + u.pn * 256;
        const f32x4 gv0 = *(const f32x4*)(gam + scol), gv1 = *(const f32x4*)(gam + scol + 128), bv0 = *(const f32x4*)(bet + scol), bv1 = *(const f32x4*)(bet + scol + 128);
        st1.run(acc, u, wr, wc, lds, wid, lane);
        const bool last = (mode == M_FC2 && l == 1);
        float* xo = (dry ? (float*)(ws + O_PART) : (last ? out : (float*)(ws + O_X))) + (size_t)u.pm * 256 * D + u.pn * 256;
        {
#pragma unroll
            for (int ai = 0; ai < 2; ++ai)
#pragma unroll
                for (int m = 0; m < 4; ++m) { int rw = wr * 64 + ai * 128 + m * 16 + rl; asm volatile("" : "+v"(rw));
#pragma unroll
                    for (int h = 0; h < 2; ++h) { const f32x2 sr = S[rw + 8 * h];
                        const f32x4 a = (acc[ai][0][m][h] - sr.x) * sr.y * gv0 + bv0, b = (acc[ai][1][m][h] - sr.x) * sr.y * gv1 + bv1; acc[ai][0][m][h] = a; acc[ai][1][m][h] = b;
                        if (last) { __builtin_nontemporal_store(a, (f32x4*)(xo + (size_t)(rw + 8 * h) * D + scol)); __builtin_nontemporal_store(b, (f32x4*)(xo + (size_t)(rw + 8 * h) * D + scol + 128)); } }
                    asm volatile("" ::: "memory"); }
        }
        if (last) return;
        PanelStats st2{(unsigned long long*)(ws + O_XB) + 65536, (unsigned*)(ws + O_CNT) + (size_t)(bank + 1) * 2048};
        const float* modn = (mode == M_WOUT) ? modl : (const float*)(ws + O_MODV) + ((size_t)(l + 1) * 3 + mr) * 12288;
        const float* shp = modn + (mode == M_WOUT ? 6144 : 0) + u.pn * 256; const float* scp = modn + (mode == M_WOUT ? 8192 : 2048) + u.pn * 256;
        const f32x4 sh0 = *(const f32x4*)(shp + scol), sh1 = *(const f32x4*)(shp + scol + 128), sc0 = *(const f32x4*)(scp + scol) + 1.0f, sc1 = *(const f32x4*)(scp + scol + 128) + 1.0f;
        st2.run(acc, u, wr, wc, lds, wid, lane);
        bf16* uo = (bf16*)(ws + (dry ? O_Y : O_U)) + (size_t)u.pm * 256 * D + u.pn * 256;
        {
#pragma unroll
            for (int ai = 0; ai < 2; ++ai)
#pragma unroll
                for (int m = 0; m < 4; ++m) { int rw = wr * 64 + ai * 128 + m * 16 + rl; asm volatile("" : "+v"(rw));
#pragma unroll
                    for (int h = 0; h < 2; ++h) { const f32x2 sr = S[rw + 8 * h];
                        *(f32x4*)(xo + (size_t)(rw + 8 * h) * D + scol) = acc[ai][0][m][h]; *(f32x4*)(xo + (size_t)(rw + 8 * h) * D + scol + 128) = acc[ai][1][m][h];
                        const f32x4 a = (acc[ai][0][m][h] - sr.x) * sr.y * sc0 + sh0, b = (acc[ai][1][m][h] - sr.x) * sr.y * sc1 + sh1;
                        u32x2 wa, wb; wa.x = pk2(a[0], a[1]); wa.y = pk2(a[2], a[3]); wb.x = pk2(b[0], b[1]); wb.y = pk2(b[2], b[3]);
                        *(u32x2*)(uo + (size_t)(rw + 8 * h) * D + scol) = wa; *(u32x2*)(uo + (size_t)(rw + 8 * h) * D + scol + 128) = wb; }
                    asm volatile("" ::: "memory"); }
        }
    }
};

__device__ __forceinline__ float wave_sum(float v) {
#pragma unroll
    for (int o = 1; o < 64; o <<= 1) v += __shfl_xor(v, o);
    return v;
}

__device__ __forceinline__ void transpose_item(const float* W, int ldw, int Kd, bf16* WT, LAS float* scr, int k0, int n0s, int n0d, int lane) {
    float tv[32];
#pragma unroll
    for (int i = 0; i < 32; ++i) tv[i] = __builtin_nontemporal_load(&W[(size_t)(k0 + 2 * i + (lane >> 5)) * ldw + n0s + (lane & 31)]);
#pragma unroll
    for (int i = 0; i < 32; ++i) scr[(2 * i + (lane >> 5)) * 33 + (lane & 31)] = tv[i];
    asm volatile("s_waitcnt lgkmcnt(0)" ::: "memory");
    const int c = lane & 7;
#pragma unroll
    for (int j = 0; j < 4; ++j) { const int n = (lane >> 3) + 8 * j; const LAS float* s = scr + (8 * c) * 33 + n;
        u32x4 o; o.x = pk2(s[0 * 33], s[1 * 33]); o.y = pk2(s[2 * 33], s[3 * 33]); o.z = pk2(s[4 * 33], s[5 * 33]); o.w = pk2(s[6 * 33], s[7 * 33]);
        *(u32x4*)(WT + (size_t)(n0d + n) * Kd + k0 + 8 * c) = o; }
    asm volatile("s_waitcnt lgkmcnt(0)" ::: "memory");
}

constexpr int CONV_IA = 32 * 128, CONV_IB = 32 * 64, CONV_IC1 = 32 * 256, CONV_IC2 = 128 * 64, CONV_PER = CONV_IA + CONV_IB + CONV_IC1 + CONV_IC2;
__device__ __forceinline__ void convert_items(const Frame& F, LAS unsigned char* lds, int first, int stride, int base, int end) {
    LAS float* scr = (LAS float*)(lds + 40960 + F.wave * 8448);
    for (int it = base + first; it < end; it += stride) { const int lw = it / CONV_PER; int r = it % CONV_PER;
        if (r < CONV_IA) { const int kb = r >> 7, nb = r & 127, sc = nb * 32; const int dst = sc < 2048 ? sc : (sc < 3072 ? 3072 + (sc - 2048) : 2048 + (sc - 3072));
            transpose_item(F.in[I_WIN] + (size_t)lw * 2048 * 4608, 4608, 2048, WSP(bf16, O_WIN) + (size_t)lw * 5120 * 2048, scr, kb * 64, sc, dst, F.lane); continue; }
        r -= CONV_IA;
        if (r < CONV_IB) { const int kb = r >> 6, nb = r & 63; transpose_item(F.in[I_WOUT] + (size_t)lw * 2048 * 2048, 2048, 2048, WSP(bf16, O_WOUT) + (size_t)lw * 2048 * 2048, scr, kb * 64, nb * 32, nb * 32, F.lane); continue; }
        r -= CONV_IB;
        if (r < CONV_IC1) { const int kb = r >> 8, nb = r & 255; transpose_item(F.in[I_WFC1] + (size_t)lw * 2048 * 8192, 8192, 2048, WSP(bf16, O_W1) + (size_t)lw * 8192 * 2048, scr, kb * 64, nb * 32, nb * 32, F.lane); continue; }
        r -= CONV_IC1;
        { const int kb = r >> 6, nb = r & 63; transpose_item(F.in[I_WFC2] + (size_t)lw * 8192 * 2048, 2048, 8192, WSP(bf16, O_W2) + (size_t)lw * 2048 * 8192, scr, kb * 64, nb * 32, nb * 32, F.lane); }
    }
}

__device__ __forceinline__ void phase_prologue(const Frame& F_, LAS unsigned char* lds) {
    Frame F = F_; F.lane = lane_id_fresh(); asm volatile("" : "+v"(F.lane), "+s"(F.wave)); F.tid = F.wave * 64 + F.lane;
    LAS f32x2* tabL = (LAS f32x2*)lds;
    LAS f32x2* tabC = (LAS f32x2*)(lds + 32768);
    for (int q = F.tid; q < 4096; q += NTHR) { float s, c; sincospif((float)q * (1.0f / 2048.0f), &s, &c); tabL[q] = (f32x2){c, s}; }
    if (F.tid < 128) { float s, c; sincospif((float)F.tid * (1.0f / 64.0f), &s, &c); tabC[F.tid] = (f32x2){c, s}; }
    __syncthreads();
    const int gt = F.bid * NTHR + F.tid, NGT = F.G * NTHR;
    for (int _r = 0; _r < REP_PA; ++_r) { const float sc = 0.00138106793f;
      bf16* Dm = WSP(bf16, O_DFT);
      for (int it = gt; it < 2048 * 1024; it += NGT) { const int k = it >> 10, ch = it & 1023, part = ch >> 9, t0 = (ch & 511) * 8;
          float v[8];
#pragma unroll
          for (int j = 0; j < 8; ++j) { const f32x2 cs = tabL[(k * (t0 + j)) & 4095]; v[j] = part ? -cs.y * sc : cs.x * sc; }
          u32x4 o; o.x = pk2(v[0], v[1]); o.y = pk2(v[2], v[3]); o.z = pk2(v[4], v[5]); o.w = pk2(v[6], v[7]);
          *(u32x4*)(Dm + (size_t)k * 8192 + ch * 8) = o; }
      const float scc = 0.00552427173f;
      bf16* Dc = WSP(bf16, O_DFTC);
      for (int it = gt; it < 256 * 64; it += NGT) { const int k = it >> 6, ch = it & 63, part = ch >> 5, t0 = (ch & 31) * 8;
          float v[8];
#pragma unroll
          for (int j = 0; j < 8; ++j) { const f32x2 cs = tabL[((k * (t0 + j)) & 255) * 16]; v[j] = part ? -cs.y * scc : cs.x * scc; }
          u32x4 o; o.x = pk2(v[0], v[1]); o.y = pk2(v[2], v[3]); o.z = pk2(v[4], v[5]); o.w = pk2(v[6], v[7]);
          *(u32x4*)(Dc + (size_t)k * 512 + ch * 8) = o; } }
    for (int _r = 0; _r < REP_PB; ++_r) { bf16* Wf = WSP(bf16, O_WFOLD);
      for (int it = gt; it < 2 * 1024 * 512; it += NGT) { const int jj = it & 511, np = (it >> 9) & 1023, lw = it >> 19; const int part = np >> 9, nout = np & 511, g = jj >> 7, c = jj & 127;
          const float* fw = F.in[I_FNOW] + ((size_t)lw * 512 + g * 128) * 512 + nout; float s = 0.f;
          for (int m = 0; m < 128; ++m) { const f32x2 cs = tabC[(m * c) & 127]; s += (part ? cs.y : cs.x) * fw[(size_t)m * 512]; }
          Wf[it] = (bf16)(pk2(s, 0.f) & 0xffffu); } }
    for (int it = gt; it < 2048; it += NGT) WSP(float, O_SPT)[it] = -8.0f * log1pf(expf(-F.in[I_LAM][it]));
    { bf16* Wg = WSP(bf16, O_WG);
      for (int it = gt; it < 2 * 2048 * 64; it += NGT) { const int kc = it & 63, n = (it >> 6) & 2047, lw = it >> 17; const int pn = n >> 8, half = (n >> 7) & 1, cc = n & 127, d = pn >> 2, blk = pn & 3, k0 = kc * 8;
          u32x4 o = (u32x4){0u, 0u, 0u, 0u};
          if ((k0 >> 7) == blk) { const float* w = (half ? F.in[I_WX] : F.in[I_WA]) + ((((size_t)lw * 2 + d) * 4 + blk) * 128 + (k0 & 127)) * 128 + cc;
              o.x = pk2(w[0], w[128]); o.y = pk2(w[256], w[384]); o.z = pk2(w[512], w[640]); o.w = pk2(w[768], w[896]); }
          *(u32x4*)(Wg + (size_t)it * 8) = o; } }
    { bf16* Wf = WSP(bf16, O_WF);
      for (int it = gt; it < 2 * 2048 * 64; it += NGT) { const int jc = it & 63, kd = (it >> 6) & 2047, lw = it >> 17;
          const float* w = F.in[I_WIN] + ((size_t)lw * 2048 + kd) * 4608 + 4096 + jc * 8; const f32x4 a = *(const f32x4*)w, b = *(const f32x4*)(w + 4);
          u32x4 o; o.x = pk2(a[0], a[1]); o.y = pk2(a[2], a[3]); o.z = pk2(b[0], b[1]); o.w = pk2(b[2], b[3]);
          *(u32x4*)(Wf + (size_t)it * 8) = o; } }
    for (int _r = 0; _r < REP_PC; ++_r) convert_items(F, lds, F.bid * NWAVES + F.wave, F.G * NWAVES, 0, CONV_IA);
    if (F.G != 256) convert_items(F, lds, F.bid * NWAVES + F.wave, F.G * NWAVES, CONV_IA, 2 * CONV_PER);
    __syncthreads();
    { LAS float* sc = (LAS float*)(lds + 40960);
      LAS float* red = (LAS float*)(lds + 40960 + 24576);
      for (int i = F.tid; i < 3 * 2048; i += NTHR) { const int r = i >> 11, k = i & 2047; const float v = (r < 2) ? F.in[I_C][r * 2048 + k] : F.in[I_CCTX][k]; sc[i] = v * sigmoidf_(v); }
      __syncthreads();
      for (int _r = 0; _r < REP_PD; ++_r) for (int strip = F.bid; strip < 256; strip += F.G) {
          const int lw = strip >> 7, n0 = (strip & 127) * 96;
          if (F.tid < 384) { const int cl = F.tid % 24, rg = F.tid / 24; const float* w = F.in[I_WMOD] + ((size_t)lw * 2048 + rg * 128) * 12288 + n0 + cl * 4;
              f32x4 a0 = (f32x4){0.f, 0.f, 0.f, 0.f}, a1 = a0, a2 = a0;
#pragma unroll 16
              for (int k = 0; k < 128; ++k) { const f32x4 wv = __builtin_nontemporal_load((const f32x4*)(w + (size_t)k * 12288)); const int kk = rg * 128 + k;
                  a0 += wv * sc[kk]; a1 += wv * sc[2048 + kk]; a2 += wv * sc[4096 + kk]; }
#pragma unroll
              for (int j = 0; j < 4; ++j) { red[(rg * 3 + 0) * 96 + cl * 4 + j] = a0[j]; red[(rg * 3 + 1) * 96 + cl * 4 + j] = a1[j]; red[(rg * 3 + 2) * 96 + cl * 4 + j] = a2[j]; } }
          __syncthreads();
          if (F.tid < 288) { const int r = F.tid / 96, cidx = F.tid % 96; float s = F.in[I_BMOD][(size_t)lw * 12288 + n0 + cidx];
              for (int rg = 0; rg < 16; ++rg) s += red[(rg * 3 + r) * 96 + cidx];
              WSP(float, O_MODV)[((size_t)lw * 3 + r) * 12288 + n0 + cidx] = s; }
          __syncthreads();
      } }
}

__device__ __forceinline__ void ln_stats(const f32x4 (&v)[8], float& mean, float& rstd) {
    float s = 0.f;
#pragma unroll
    for (int j = 0; j < 8; ++j) s += (v[j][0] + v[j][1]) + (v[j][2] + v[j][3]);
    mean = wave_sum(s) * (1.0f / D); float q = 0.f;
#pragma unroll
    for (int j = 0; j < 8; ++j) { const f32x4 d = v[j] - mean; q += (d[0] * d[0] + d[1] * d[1]) + (d[2] * d[2] + d[3] * d[3]); }
    rstd = 1.0f / sqrtf(wave_sum(q) * (1.0f / D) + LN_EPS);
}
__device__ __forceinline__ void phase_ln(const Frame& F_, int kind, int row_begin, int nrows, const float* gw_, const float* bw_, float* xdst, bool do_u, const float* modl, int sh_off, int sc_off, int cparts = 0, const float* cres = nullptr, const float* cgate = nullptr, const float* cbias = nullptr) {
    Frame F = F_; F.lane = lane_id_fresh(); asm volatile("" : "+v"(F.lane), "+s"(F.wave)); F.tid = F.wave * 64 + F.lane;
    int gw = F.bid * NWAVES + F.wave, NGW = F.G * NWAVES;
    if (kind == 0 && F.G == 256) { if (F.bid < 64) return; gw -= 64 * NWAVES; NGW -= 64 * NWAVES; }
    for (int m = row_begin + gw; m < nrows; m += NGW) {
        const float* src;
        if (kind == 0) src = (m < ML) ? F.in[I_X] + (size_t)m * D : F.in[I_CTX] + (size_t)(m - ML) * D;
        else src = WSP(const float, O_Y) + (size_t)m * D;
        f32x4 v[8];
        if (cparts > 0 && m >= ML) {
            const float* cp = WSP(const float, O_CPART) + (size_t)(m - ML) * D; const float* rs = cres + (size_t)(m - ML) * D;
#pragma unroll
            for (int j = 0; j < 8; ++j) v[j] = cbias ? *(const f32x4*)(cbias + j * 256 + F.lane * 4) : (f32x4){0.f, 0.f, 0.f, 0.f};
#pragma unroll 1
            for (int ks = 0; ks < cparts; ks += 2) {
                f32x4 p0[8], p1[8];
#pragma unroll
                for (int j = 0; j < 8; ++j) { p0[j] = __builtin_nontemporal_load((const f32x4*)(cp + (size_t)ks * 512 * D + j * 256 + F.lane * 4)); p1[j] = __builtin_nontemporal_load((const f32x4*)(cp + (size_t)(ks + 1) * 512 * D + j * 256 + F.lane * 4)); }
#pragma unroll
                for (int j = 0; j < 8; ++j) v[j] += p0[j] + p1[j];
                asm volatile("" ::: "memory"); }
#pragma unroll
            for (int j = 0; j < 8; ++j) { const int co = j * 256 + F.lane * 4; v[j] = *(const f32x4*)(rs + co) * ALPHA + *(const f32x4*)(cgate + co) * v[j]; }
        } else {
#pragma unroll
        for (int j = 0; j < 8; ++j) v[j] = __builtin_nontemporal_load((const f32x4*)(src + j * 256 + F.lane * 4));
        }
        float mean, rstd;
        if (kind == 1) {
            ln_stats(v, mean, rstd);
#pragma unroll
            for (int j = 0; j < 8; ++j) { const f32x4 g = *(const f32x4*)(gw_ + j * 256 + F.lane * 4), b = *(const f32x4*)(bw_ + j * 256 + F.lane * 4);
                v[j] = (v[j] - mean) * rstd * g + b; *(f32x4*)(xdst + (size_t)m * D + j * 256 + F.lane * 4) = v[j]; }
        }
        if (do_u) {
            ln_stats(v, mean, rstd);
            const int mr = (m < 4096) ? 0 : (m < ML ? 1 : 2);
            const float* mp = modl + (size_t)mr * 12288;
            bf16* up = WSP(bf16, O_U) + (size_t)m * D;
#pragma unroll
            for (int j = 0; j < 8; ++j) { const f32x4 sh = *(const f32x4*)(mp + sh_off + j * 256 + F.lane * 4), sc = *(const f32x4*)(mp + sc_off + j * 256 + F.lane * 4);
                const f32x4 o = (v[j] - mean) * rstd * (sc + 1.0f) + sh; u32x2 w; w.x = pk2(o[0], o[1]); w.y = pk2(o[2], o[3]);
                *(u32x2*)(up + j * 256 + F.lane * 4) = w; }
        }
    }
}

__device__ __forceinline__ void phase_rope_conv(const Frame& F_, int l, LAS unsigned char* lds) {
    Frame F = F_; F.lane = lane_id_fresh(); asm volatile("" : "+v"(F.lane), "+s"(F.wave)); F.tid = F.wave * 64 + F.lane;
    LAS f32x2* tab = (LAS f32x2*)lds;
    for (int i = F.tid; i < 2048; i += NTHR) { const int pos = i >> 5, ii = i & 31; const float inv = powf(10000.0f, -(float)ii * (1.0f / 32.0f)); const float ang = (float)pos * inv; tab[i] = (f32x2){cosf(ang), sinf(ang)}; }
    __syncthreads();
    const int gt = F.bid * NTHR + F.tid, NGT = F.G * NTHR;
    const bf16* P1 = WSP(const bf16, O_P1);
    for (int it0 = gt; it0 < ML * 128; it0 += 4 * NGT) {
        u32x4 av[4], bv[4];
#pragma unroll
        for (int q = 0; q < 4; ++q) { const int it = it0 + q * NGT; if (it < ML * 128) { const int ig = it & 3, half = (it >> 2) & 1, h = (it >> 3) & 7, qk = (it >> 6) & 1, tok = it >> 7;
            const bf16* src = P1 + (size_t)tok * NP1 + qk * 1024 + h * 128 + half * 64 + ig * 8; av[q] = __builtin_nontemporal_load((const u32x4*)src); bv[q] = __builtin_nontemporal_load((const u32x4*)(src + 32)); } }
#pragma unroll
        for (int q = 0; q < 4; ++q) { const int it = it0 + q * NGT; if (it < ML * 128) { const int ig = it & 3, half = (it >> 2) & 1, h = (it >> 3) & 7, qk = (it >> 6) & 1, tok = it >> 7;
            const int t = tok & 4095, pos = half ? (t & 63) : (t >> 6);
            const unsigned aw[4] = {av[q].x, av[q].y, av[q].z, av[q].w}, bw[4] = {bv[q].x, bv[q].y, bv[q].z, bv[q].w};
            float o1[8], o2[8];
#pragma unroll
            for (int j = 0; j < 8; ++j) { const float x1 = bf2f((aw[j >> 1] >> ((j & 1) * 16)) & 0xffffu), x2 = bf2f((bw[j >> 1] >> ((j & 1) * 16)) & 0xffffu);
                const f32x2 cs = tab[pos * 32 + ig * 8 + j]; o1[j] = x1 * cs.x - x2 * cs.y; o2[j] = x1 * cs.y + x2 * cs.x; }
            bf16* dst = qk ? WSP(bf16, O_KR) + ((size_t)h * MT + tok) * 128 + half * 64 + ig * 8 : WSP(bf16, O_QR) + (size_t)tok * 1024 + h * 128 + half * 64 + ig * 8;
            u32x4 w1, w2; w1.x = pk2(o1[0], o1[1]); w1.y = pk2(o1[2], o1[3]); w1.z = pk2(o1[4], o1[5]); w1.w = pk2(o1[6], o1[7]);
            w2.x = pk2(o2[0], o2[1]); w2.y = pk2(o2[2], o2[3]); w2.z = pk2(o2[4], o2[5]); w2.w = pk2(o2[6], o2[7]);
            *(u32x4*)dst = w1; *(u32x4*)(dst + 32) = w2; } }
    }
    for (int it = gt; it < 512 * 128; it += NGT) { const int c8 = it & 15, h = (it >> 4) & 7, tok = ML + (it >> 7);
        *(u32x4*)(WSP(bf16, O_KR) + ((size_t)h * MT + tok) * 128 + c8 * 8) = *(const u32x4*)(P1 + (size_t)tok * NP1 + 1024 + h * 128 + c8 * 8); }
    const float* cw = F.in[I_CONVW] + (size_t)l * 4 * 512; const float* cb = F.in[I_CONVB] + (size_t)l * 512;
    for (int it = gt; it < MT * 64; it += NGT) { const int c8 = it & 63, m = it >> 6;
        int pos, len; if (m < ML) { pos = m & 4095; len = 4096; } else { pos = (m - ML) & 255; len = 256; }
        float acc[8];
        { const f32x4 b0 = *(const f32x4*)(cb + c8 * 8), b1 = *(const f32x4*)(cb + c8 * 8 + 4);
#pragma unroll
          for (int j = 0; j < 4; ++j) { acc[j] = b0[j]; acc[4 + j] = b1[j]; } }
#pragma unroll
        for (int jj = 0; jj < 4; ++jj) { const int p = pos + jj - 2; if (p < 0 || p >= len) continue;
            const u32x4 xv = *(const u32x4*)(P1 + (size_t)(m + jj - 2) * NP1 + 2048 + c8 * 8); const unsigned xw[4] = {xv.x, xv.y, xv.z, xv.w};
            const f32x4 w0 = *(const f32x4*)(cw + jj * 512 + c8 * 8), w1 = *(const f32x4*)(cw + jj * 512 + c8 * 8 + 4);
#pragma unroll
            for (int j = 0; j < 8; ++j) { const float x = bf2f((xw[j >> 1] >> ((j & 1) * 16)) & 0xffffu); acc[j] += x * (j < 4 ? w0[j & 3] : w1[j & 3]); } }
        u32x4 o; o.x = pk2(acc[0], acc[1]); o.y = pk2(acc[2], acc[3]); o.z = pk2(acc[4], acc[5]); o.w = pk2(acc[6], acc[7]);
        *(u32x4*)(WSP(bf16, O_XC) + (size_t)m * 512 + c8 * 8) = o; }
}

constexpr float ATT_SCALE = 0.08838834764831845f, LOG2E = 1.4426950408889634f;
struct AttTile { bf16x8 k[8]; bf16x8 v[8]; };
__device__ __forceinline__ void att_offsets(unsigned (&koff)[2], unsigned (&voff)[2], int lane, int w) {
#pragma unroll
    for (int ii = 0; ii < 2; ++ii) { const int key = 8 * w + 4 * ii + (lane >> 4), sw = (((key >> 3) & 3) << 2) | (key & 3), chunk = (lane & 15) ^ sw; koff[ii] = (unsigned)(key * 128 + chunk * 8) * 2u;
        const int d = 16 * w + 8 * ii + (lane >> 3), cc = (lane & 7) ^ ((d >> 1) & 7); voff[ii] = (unsigned)(d * 64 + cc * 8) * 2u; }
}
__device__ __forceinline__ void att_issue(LAS unsigned char* buf, int w, const bf16* krow, const bf16* vrow, const unsigned (&koff)[2], const unsigned (&voff)[2]) {
#pragma unroll
    for (int ii = 0; ii < 2; ++ii) __builtin_amdgcn_global_load_lds((const unsigned*)((const char*)krow + koff[ii]), (LAS unsigned*)(buf + (2 * w + ii) * 1024), 16, 0, 0);
#pragma unroll
    for (int ii = 0; ii < 2; ++ii) __builtin_amdgcn_global_load_lds((const unsigned*)((const char*)vrow + voff[ii]), (LAS unsigned*)(buf + 16384 + (2 * w + ii) * 1024), 16, 0, 0);
}
__device__ __forceinline__ void att_fetch(AttTile& t, const LAS unsigned char* buf, int cb, int ql, int g, int km) {
#pragma unroll
    for (int s = 0; s < 4; ++s)
#pragma unroll
        for (int sub = 0; sub < 2; ++sub) { const int key = cb + km + 4 * sub, sw = (((key >> 3) & 3) << 2) | (key & 3);
            t.k[2 * s + sub] = *(const LAS bf16x8*)(buf + (key * 16 + ((4 * s + g) ^ sw)) * 16); }
#pragma unroll
    for (int dt = 0; dt < 8; ++dt) { const int d = 16 * dt + ql; t.v[dt] = *(const LAS bf16x8*)(buf + 16384 + (d * 8 + (((cb >> 3) + g) ^ ((d >> 1) & 7))) * 16); }
}
template <bool BAND>
__device__ __forceinline__ void att_compute(const AttTile& t, const bf16x8 (&q)[4], f32x4 (&o)[8], float& mrun, float& lsum, const LAS float* rpr, int kc0, int qc, int cs) {
    f32x4 s0 = (f32x4){0.f, 0.f, 0.f, 0.f}, s1 = s0;
#pragma unroll
    for (int s = 0; s < 4; ++s) { s0 = __builtin_amdgcn_mfma_f32_16x16x32_bf16(t.k[2 * s], q[s], s0, 0, 0, 0); s1 = __builtin_amdgcn_mfma_f32_16x16x32_bf16(t.k[2 * s + 1], q[s], s1, 0, 0, 0); }
    if (BAND) {
        float ba[4], bb[4];
#pragma unroll
        for (int i = 0; i < 4; ++i) { const int ka = kc0 + i, kb = ka + 4; ba[i] = rpr[min(max(ka - qc + 15, 0), 30)]; bb[i] = rpr[min(max(kb - qc + 15, 0), 30)]; }
#pragma unroll
        for (int i = 0; i < 4; ++i) { const int ka = kc0 + i, kb = ka + 4;
            const bool va = (ka >= cs) && (ka < cs + 16), vb = (kb >= cs) && (kb < cs + 16);
            s0[i] = va ? s0[i] * ATT_SCALE + ba[i] : -1e30f; s1[i] = vb ? s1[i] * ATT_SCALE + bb[i] : -1e30f; }
    } else { s0 = s0 * ATT_SCALE; s1 = s1 * ATT_SCALE; }
    float tmax = fmaxf(fmaxf(fmaxf(s0[0], s0[1]), fmaxf(s0[2], s0[3])), fmaxf(fmaxf(s1[0], s1[1]), fmaxf(s1[2], s1[3])));
    tmax = fmaxf(tmax, __shfl_xor(tmax, 16)); tmax = fmaxf(tmax, __shfl_xor(tmax, 32));
    const float mnew = fmaxf(mrun, tmax); const bool grew = __builtin_amdgcn_ballot_w64(mnew > mrun) != 0ull;
    const float corr = __builtin_amdgcn_exp2f((mrun - mnew) * LOG2E); mrun = mnew;
    const float ml = mnew * LOG2E;
    float p0[4], p1[4], ps = 0.f;
#pragma unroll
    for (int i = 0; i < 4; ++i) { p0[i] = (s0[i] > -1e29f) ? __builtin_amdgcn_exp2f(s0[i] * LOG2E - ml) : 0.f; p1[i] = (s1[i] > -1e29f) ? __builtin_amdgcn_exp2f(s1[i] * LOG2E - ml) : 0.f; ps += p0[i] + p1[i]; }
    lsum = lsum * corr + ps;
    if (grew) {
#pragma unroll
        for (int dt = 0; dt < 8; ++dt) o[dt] = o[dt] * corr;
    }
    union { u32x4 u; bf16x8 v; } pb; pb.u.x = pk2(p0[0], p0[1]); pb.u.y = pk2(p0[2], p0[3]); pb.u.z = pk2(p1[0], p1[1]); pb.u.w = pk2(p1[2], p1[3]);
#pragma unroll
    for (int dt = 0; dt < 8; ++dt) o[dt] = __builtin_amdgcn_mfma_f32_16x16x32_bf16(t.v[dt], pb.v, o[dt], 0, 0, 0);
}
__device__ __forceinline__ void phase_attention(const Frame& F_, int l, LAS unsigned char* lds) {
    Frame F = F_; F.lane = lane_id_fresh(); asm volatile("" : "+v"(F.lane), "+s"(F.wave)); F.tid = F.wave * 64 + F.lane;
    const int ql = F.lane & 15, g = F.lane >> 4, km = 8 * (ql >> 2) + (ql & 3);
    const int w = F.wave, wg = w & 3, rsel = w >> 2;
    const bf16* P1 = WSP(const bf16, O_P1); const bf16* QR = WSP(const bf16, O_QR); const bf16* KR = WSP(const bf16, O_KR); const bf16* VT = WSP(const bf16, O_VT);
    LAS float* tabB = (LAS float*)(lds + 131072 + 1024);
    for (int i = F.tid; i < 8 * 465; i += NTHR) tabB[i] = F.in[I_RPB][(size_t)l * 8 * 465 + i];
    __syncthreads();
    unsigned koff[2], voff[2]; att_offsets(koff, voff, F.lane, w);
    const int nbt = 512 + (l == 0 ? 32 : 0);
    for (int bi = 0; ; ++bi) {
        int bt = F.bid + bi * F.G;
        if (F.G == 256 && bi == 2) bt = (l == 0 && F.bid >= 32 && F.bid < 64) ? 512 + (F.bid - 32) : nbt;
        if (bt >= nbt) break;
        const bool lat = bt < 512;
        int b, h, tq, r = 0, r0 = 0, qc = 0;
        if (lat) { const int B = bt & 255, x = B & 7, slot = B >> 3; b = bt >> 8; h = x; r0 = 2 * slot; r = r0 + rsel; qc = 16 * wg + ql; tq = b * 4096 + r * 64 + qc; }
        else { const int q = bt - 512; b = q >> 4; h = (q >> 1) & 7; tq = ML + b * 256 + (q & 1) * 128 + w * 16 + ql; }
        const int cb = (wg == 0) ? 0 : (wg == 1 ? 8 : (wg == 2 ? 24 : 32));
        const int rs0 = min(max(r0 - 4, 0), 56), rs = min(max(r - 4, 0), 56), cs = min(max(qc - 8, 0), 48);
        const LAS float* rp = tabB + h * 465;
        const unsigned kband = (unsigned)((h * MT + b * 4096) * 128);
        const unsigned kctx = (unsigned)((h * MT + ML + b * 256) * 128);
        const unsigned vband = (unsigned)((b * 64) * 65536 + h * 8192);
        const unsigned vctx = (unsigned)((128 + b * 4) * 65536 + h * 8192);
        const int s0 = lat ? 0 : 9, nst = 13;
#define ATT_ISSUE(S) do { const int S_ = min((S), nst - 1); LAS unsigned char* bf_ = lds + ((S) & 3) * 32768; \
        if (S_ < 9) { const int R_ = min(rs0 + S_, 63); att_issue(bf_, w, KR + (kband + (unsigned)R_ * 8192u), VT + (vband + (unsigned)R_ * 65536u), koff, voff); } \
        else att_issue(bf_, w, KR + (kctx + (unsigned)(S_ - 9) * 8192u), VT + (vctx + (unsigned)(S_ - 9) * 65536u), koff, voff); } while (0)
        bf16x8 qr[4], qn[4];
#pragma unroll
        for (int s = 0; s < 4; ++s) { qn[s] = *(const bf16x8*)(P1 + (size_t)tq * NP1 + h * 128 + 8 * g + 32 * s); qr[s] = lat ? __builtin_nontemporal_load((const bf16x8*)(QR + (size_t)tq * 1024 + h * 128 + 8 * g + 32 * s)) : qn[s]; }
        __builtin_amdgcn_s_barrier();
        ATT_ISSUE(s0); ATT_ISSUE(s0 + 1); ATT_ISSUE(s0 + 2);
        f32x4 o[8];
#pragma unroll
        for (int dt = 0; dt < 8; ++dt) o[dt] = (f32x4){0.f, 0.f, 0.f, 0.f};
        float mrun = -1e30f, lsum = 0.f;
        for (int S = s0; S < nst; ++S) {
            asm volatile("s_waitcnt vmcnt(8)" ::: "memory");
            __builtin_amdgcn_s_barrier();
            asm volatile("" ::: "memory");
            ATT_ISSUE(S + 3);
            const LAS unsigned char* bf = lds + (S & 3) * 32768;
            AttTile t;
            if (S < 9) { const int R = rs0 + S;
                if (R >= rs && R < rs + 8) { att_fetch(t, bf, cb, ql, g, km); att_compute<true>(t, qr, o, mrun, lsum, rp + (R - r + 7) * 31, cb + 8 * g, qc, cs); } }
            else { att_fetch(t, bf, 0, ql, g, km); att_compute<false>(t, qn, o, mrun, lsum, rp, 0, 0, 0);
                   att_fetch(t, bf, 32, ql, g, km); att_compute<false>(t, qn, o, mrun, lsum, rp, 0, 0, 0); }
            asm volatile("s_waitcnt lgkmcnt(0)" ::: "memory");
        }
#undef ATT_ISSUE
        lsum += __shfl_xor(lsum, 16); lsum += __shfl_xor(lsum, 32);
        const float inv = 1.0f / lsum;
        bf16* op = WSP(bf16, O_MIX) + (size_t)tq * D + h * 128 + 4 * g;
#pragma unroll
        for (int dt = 0; dt < 8; ++dt) { u32x2 w2; w2.x = pk2(o[dt][0] * inv, o[dt][1] * inv); w2.y = pk2(o[dt][2] * inv, o[dt][3] * inv); *(u32x2*)(op + dt * 16) = w2; }
        asm volatile("s_waitcnt vmcnt(0)" ::: "memory");
    }
    __syncthreads();
}

__device__ __forceinline__ int chunk_tok0(int b, int ci) { return ci < 4 ? ML + b * 256 + ci * 64 : b * 4096 + (ci - 4) * 64; }
__device__ __forceinline__ void phase_scan1(const Frame& F_) {
    Frame F = F_; F.lane = lane_id_fresh(); asm volatile("" : "+v"(F.lane), "+s"(F.wave)); F.tid = F.wave * 64 + F.lane;
    const int gw = F.bid * NWAVES + F.wave, NGW = F.G * NWAVES;
    for (int task = gw; task < 2176; task += NGW) {
        const int ci = task % 68, cgp = (task / 68) & 7, dir = (task / 544) & 1, b = task / 1088;
        const int c = cgp * 64 + F.lane; const size_t base = ((size_t)dir * MT + chunk_tok0(b, ci)) * 512 + c;
        const unsigned* pa = WSP(const unsigned, O_AA) + base;
        float h = 0.f, Ls = 0.f;
        for (int i0 = 0; i0 < 64; i0 += 16) { unsigned wv[16];
#pragma unroll
            for (int k = 0; k < 16; ++k) { const int ii = dir ? 63 - (i0 + k) : (i0 + k); wv[k] = pa[(size_t)ii * 512]; }
#pragma unroll
            for (int k = 0; k < 16; ++k) { const float la = bf2f(wv[k] & 0xffffu); h = __builtin_amdgcn_exp2f(la * LOG2E) * h + bf2f(wv[k] >> 16); Ls += la; } }
        const size_t so = ((size_t)(b * 2 + dir) * 68 + ci) * 512 + c;
        WSP(float, O_SUMA)[so] = __builtin_amdgcn_exp2f(Ls * LOG2E); WSP(float, O_SUMB)[so] = h;
    }
}
__device__ __forceinline__ float gelu_tanh(float x) { const float t = 0.7978845608028654f * (x + 0.044715f * x * x * x); return 0.5f * x * (1.0f + tanhf(t)); }
__device__ __forceinline__ void phase_scan3(const Frame& F_, int l, LAS unsigned char* lds) {
    Frame F = F_; F.lane = lane_id_fresh(); asm volatile("" : "+v"(F.lane), "+s"(F.wave)); F.tid = F.wave * 64 + F.lane;
    const int gw = F.bid * NWAVES + F.wave, NGW = F.G * NWAVES;
    LAS float* hf = (LAS float*)(lds + F.wave * 16384);
    const float* SA = WSP(const float, O_SUMA); const float* SB = WSP(const float, O_SUMB);
    if (l == 0 && F.G == 256 && F.bid >= 136) convert_items(F, lds, (F.bid - 136) * NWAVES + F.wave, 960, CONV_IA + CONV_IB + CONV_IC1, CONV_PER);
    for (int task = gw; task < 1088; task += NGW) {
        const int ci = task % 68, cgp = (task / 68) & 7, b = task / 544;
        if (l == 1 && ci < 4) continue;
        const int c = cgp * 64 + F.lane; const int tok0 = chunk_tok0(b, ci);
        { float h = 0.f; const size_t sb = ((size_t)(b * 2 + 0) * 68) * 512 + c;
          for (int c0 = 0; c0 < ci; c0 += 8) { float ca[8], cbv[8];
#pragma unroll
              for (int k = 0; k < 8; ++k) { const int cj = min(c0 + k, ci - 1); ca[k] = SA[sb + (size_t)cj * 512]; cbv[k] = SB[sb + (size_t)cj * 512]; }
#pragma unroll
              for (int k = 0; k < 8; ++k) if (c0 + k < ci) h = ca[k] * h + cbv[k]; }
          const unsigned* pa = WSP(const unsigned, O_AA) + ((size_t)tok0) * 512 + c;
          for (int i0 = 0; i0 < 64; i0 += 16) { unsigned wv[16];
#pragma unroll
              for (int k = 0; k < 16; ++k) wv[k] = __builtin_nontemporal_load(&pa[(size_t)(i0 + k) * 512]);
#pragma unroll
              for (int k = 0; k < 16; ++k) { h = __builtin_amdgcn_exp2f(bf2f(wv[k] & 0xffffu) * LOG2E) * h + bf2f(wv[k] >> 16); hf[(i0 + k) * 64 + F.lane] = h; } } }
        { float h = 0.f; const size_t sb = ((size_t)(b * 2 + 1) * 68) * 512 + c;
          const int np = (ci < 4) ? 3 - ci : 4 + (67 - ci);
          for (int p0 = 0; p0 < np; p0 += 8) { float ca[8], cbv[8];
#pragma unroll
              for (int k = 0; k < 8; ++k) { const int p = min(p0 + k, np - 1); const int cj = (p < 4) ? 3 - p : 67 - (p - 4); ca[k] = SA[sb + (size_t)cj * 512]; cbv[k] = SB[sb + (size_t)cj * 512]; }
#pragma unroll
              for (int k = 0; k < 8; ++k) if (p0 + k < np) h = ca[k] * h + cbv[k]; }
          const unsigned* pa = WSP(const unsigned, O_AA) + ((size_t)MT + tok0) * 512 + c;
          const bf16* gp = WSP(const bf16, O_P1) + (size_t)tok0 * NP1 + 2560 + c; bf16* op = WSP(bf16, O_MIX) + (size_t)tok0 * D + 1024 + c;
          for (int i0 = 0; i0 < 64; i0 += 8) { unsigned wv[8]; float gv[8];
#pragma unroll
              for (int k = 0; k < 8; ++k) { const int ii = 63 - (i0 + k); wv[k] = __builtin_nontemporal_load(&pa[(size_t)ii * 512]); gv[k] = bf2f(__builtin_nontemporal_load(&gp[(size_t)ii * NP1])); }
#pragma unroll
              for (int k = 0; k < 8; ++k) { const int ii = 63 - (i0 + k); h = __builtin_amdgcn_exp2f(bf2f(wv[k] & 0xffffu) * LOG2E) * h + bf2f(wv[k] >> 16); const float y = hf[ii * 64 + F.lane] + h;
                  op[(size_t)ii * D] = (bf16)(pk2(y * gelu_tanh(gv[k]), 0.f) & 0xffffu); } } }
    }
    const int gt = F.bid * NTHR + F.tid, NGT = F.G * NTHR;
    const float* fb = F.in[I_FNOB] + (size_t)l * 512; const float* PT = WSP(const float, O_PART);
    for (int it = gt; it < 2 * 2048 * 128; it += NGT) { const int n4 = it & 127, k = (it >> 7) & 2047, b = it >> 18;
        const bf16* p = (const bf16*)PT + ((size_t)b * 2048 + k) * 512 + n4 * 4;
        f32x4 c = (f32x4){0.f, 0.f, 0.f, 0.f}, sn = c;
#pragma unroll
        for (int ks = 0; ks < 4; ++ks) { const u32x2 wc_ = __builtin_nontemporal_load((const u32x2*)(p + (size_t)ks * 4096 * 512)), ws_ = __builtin_nontemporal_load((const u32x2*)(p + (size_t)(4 + ks) * 4096 * 512));
            c[0] += bf2f(wc_.x & 0xffffu); c[1] += bf2f(wc_.x >> 16); c[2] += bf2f(wc_.y & 0xffffu); c[3] += bf2f(wc_.y >> 16);
            sn[0] += bf2f(ws_.x & 0xffffu); sn[1] += bf2f(ws_.x >> 16); sn[2] += bf2f(ws_.y & 0xffffu); sn[3] += bf2f(ws_.y >> 16); }
        if (b == 0 && F.G == 256) { const u32x2 w8 = __builtin_nontemporal_load((const u32x2*)(p + (size_t)8 * 4096 * 512)); c[0] += bf2f(w8.x & 0xffffu); c[1] += bf2f(w8.x >> 16); c[2] += bf2f(w8.y & 0xffffu); c[3] += bf2f(w8.y >> 16); }
        const f32x4 bv = *(const f32x4*)(fb + n4 * 4);
        const f32x4 y1 = c + sn + bv, y2 = c - sn + bv;
        u32x2 w; w.x = pk2(y1[0], y1[1]); w.y = pk2(y1[2], y1[3]);
        *(u32x2*)(WSP(bf16, O_MIX) + ((size_t)b * 4096 + k) * D + 1536 + n4 * 4) = w;
        if (k > 0) { w.x = pk2(y2[0], y2[1]); w.y = pk2(y2[2], y2[3]); *(u32x2*)(WSP(bf16, O_MIX) + ((size_t)b * 4096 + 4096 - k) * D + 1536 + n4 * 4) = w; } }
    for (int task = gw; task < 1024; task += NGW) { const int n = task & 511, b = task >> 9;
        const bf16* ap = WSP(const bf16, O_ABT) + ((size_t)(b * 512 + n) * 2) * 4096 + F.lane * 64; float sacc = 0.f;
#pragma unroll
        for (int j = 0; j < 8; ++j) { const u32x4 v = *(const u32x4*)(ap + j * 8); const unsigned vw[4] = {v.x, v.y, v.z, v.w};
#pragma unroll
            for (int q = 0; q < 4; ++q) sacc += bf2f(vw[q] & 0xffffu) - bf2f(vw[q] >> 16); }
        sacc = wave_sum(sacc);
        if (F.lane == 0) WSP(bf16, O_MIX)[((size_t)b * 4096 + 2048) * D + 1536 + n] = (bf16)(pk2(sacc * 0.00138106793f + fb[n], 0.f) & 0xffffu); }
    if (l == 0) for (int it = gt; it < 512 * 128; it += NGT) { const int n4 = it & 127, r = it >> 7;
        const f32x4 v = *(const f32x4*)(PT + 16777216 + (size_t)r * 512 + n4 * 4) + *(const f32x4*)(fb + n4 * 4);
        u32x2 w; w.x = pk2(v[0], v[1]); w.y = pk2(v[2], v[3]);
        *(u32x2*)(WSP(bf16, O_MIX) + (size_t)(ML + r) * D + 1536 + n4 * 4) = w; }
}

__global__ void __launch_bounds__(NTHR, 2) mega_fwd(Params p) {
    extern __shared__ __attribute__((aligned(16))) unsigned char lds_raw[];
    LAS unsigned char* lds = (LAS unsigned char*)lds_raw;
    cg::grid_group grid = cg::this_grid();
    Frame F; F.in = p.in; F.ws = p.ws; F.out = p.out; F.tid = 0; F.lane = 0; F.wave = __builtin_amdgcn_readfirstlane(threadIdx.x >> 6); F.G = gridDim.x; F.bid = blockIdx.x;
#define modv WSP(const float, O_MODV)
    volatile LAS unsigned* xst = (volatile LAS unsigned*)(lds + 131072 + 64);
    if (threadIdx.x < 2) xst[threadIdx.x] = 0u;
    __syncthreads();
    (void)xcd_barrier_post(WSP(unsigned, O_BAR), xst);

#ifndef SK_PRO
    for (int _r = 0; _r < REP_PRO; ++_r) { phase_prologue(F, lds); __syncthreads(); }
#endif
    if (gridDim.y == 0x7fffffffu) grid.sync();
    GSYNC();
    phase_ln(F, 0, 0, MT, nullptr, nullptr, nullptr, true, modv, 0, 2048);
    __syncthreads();
#ifndef SK_FOLD
    { Sched S; S.init(F.ws, M_FOLD, 0, F.G, F.bid); EpiB E{F.ws, F.in, M_FOLD, 0}; pg8::gemm_phase<EpiB, Sched>(lds, F.wave, 512, 512, 8, S, E); }
#endif
    GSYNC();

    for (int l = 0; l < 2; ++l) {
#ifndef SK_INPROJ
        for (int _r = 0; _r < REP_INPROJ; ++_r) { __syncthreads(); Sched S; S.init(F.ws, M_INPROJ, l, F.G, F.bid); EpiB E{F.ws, F.in, M_INPROJ, l}; pg8::gemm_phase<EpiB, Sched>(lds, F.wave, 2048, 2048, 32, S, E); }
        if (l == 0 && F.G == 256 && F.bid >= 168) { Frame Fc = F; Fc.lane = lane_id_fresh(); asm volatile("" : "+v"(Fc.lane)); convert_items(Fc, lds, (F.bid - 168) * NWAVES + F.wave, 704, CONV_IA, CONV_IA + CONV_IB + CONV_IC1); }
#endif
        GSYNC();
#ifndef SK_ROPE
        for (int _r = 0; _r < REP_ELT; ++_r) { phase_rope_conv(F, l, lds); __syncthreads(); }
#endif
        GSYNC();
#ifndef SK_DFT
        for (int _r = 0; _r < REP_DFTG; ++_r) { __syncthreads(); Sched S; S.init(F.ws, M_DFT, l, F.G, F.bid); EpiF E{F.ws, F.in, M_DFT, l}; pg8::gemm_phase<EpiF, Sched>(lds, F.wave, 8192, 8192, 16, S, E); }
        if (F.G == 256) { __syncthreads(); Sched S; S.init(F.ws, M_DFT2, l, F.G, F.bid); EpiF E{F.ws, F.in, M_DFT2, l}; pg8::gemm_phase<EpiF, Sched>(lds, F.wave, 8192, 8192, 8, S, E); }
#endif
        __syncthreads();
#ifndef SK_GATES
        for (int _r = 0; _r < REP_DFTG; ++_r) { __syncthreads(); Sched S; S.init(F.ws, M_GATES, l, F.G, F.bid); EpiF E{F.ws, F.in, M_GATES, l}; pg8::gemm_phase<EpiF, Sched>(lds, F.wave, 512, 512, 2, S, E); }
        if (l == 0) { __syncthreads(); Sched S; S.init(F.ws, M_CDFT, l, F.G, F.bid); EpiF E{F.ws, F.in, M_CDFT, l}; pg8::gemm_phase<EpiF, Sched>(lds, F.wave, 512, 512, 8, S, E); }
#endif
#ifndef SK_ATT
        for (int _r = 0; _r < REP_ATT; ++_r) phase_attention(F, l, lds);
#endif
        GSYNC();
#ifndef SK_SCAN
        for (int _r = 0; _r < REP_ELT; ++_r) phase_scan1(F);
#endif
        GSYNC();
#ifndef SK_SCAN
        for (int _r = 0; _r < REP_ELT; ++_r) { phase_scan3(F, l, lds); __syncthreads(); }
#endif
        GSYNC();
#ifndef SK_WOUT
        for (int _r = 0; _r < REP_WOUT; ++_r) { __syncthreads(); Sched S; S.init(F.ws, M_WOUT, l, F.G, F.bid); EpiLN E{F.ws, F.in, F.out, M_WOUT, l, _r < REP_WOUT - 1}; pg8::gemm_phase<EpiLN, Sched>(lds, F.wave, 2048, 2048, 32, S, E); }
        if (l == 0) { __syncthreads(); Sched S; S.init(F.ws, M_WOUTC, l, F.G, F.bid); EpiF E{F.ws, F.in, M_WOUTC, l}; pg8::gemm_phase<EpiF, Sched>(lds, F.wave, 2048, 2048, 8, S, E); }
#endif
        GSYNC();
        if (l == 0) {
            for (int _r = 0; _r < REP_ELT; ++_r) phase_ln(F, 1, ML, MT, F.in[I_LN1G], F.in[I_LN1B], WSP(float, O_X), true, modv, 6144, 8192, 4, F.in[I_CTX], modv + 2 * 12288 + 4096, nullptr);
            GSYNC();
        }
#ifndef SK_FC1
        for (int _r = 0; _r < REP_FC1; ++_r) { __syncthreads(); Sched S; S.init(F.ws, M_FC1, l, F.G, F.bid); EpiB E{F.ws, F.in, M_FC1, l}; pg8::gemm_phase<EpiB, Sched>(lds, F.wave, 2048, 2048, 32, S, E); }
        if (l == 0 && F.G == 256 && F.bid >= 64) { Frame Fc = F; Fc.lane = lane_id_fresh(); asm volatile("" : "+v"(Fc.lane)); convert_items(Fc, lds, (F.bid - 64) * NWAVES + F.wave, 1536, CONV_PER, 2 * CONV_PER); }
#endif
        GSYNC();
#ifndef SK_FC2
        for (int _r = 0; _r < REP_FC2; ++_r) { __syncthreads(); Sched S; S.init(F.ws, M_FC2, l, F.G, F.bid); EpiLN E{F.ws, F.in, F.out, M_FC2, l, _r < REP_FC2 - 1}; pg8::gemm_phase<EpiLN, Sched>(lds, F.wave, 8192, 8192, 128, S, E); }
        if (l == 0) { __syncthreads(); Sched S; S.init(F.ws, M_FC2C, l, F.G, F.bid); EpiF E{F.ws, F.in, M_FC2C, l}; pg8::gemm_phase<EpiF, Sched>(lds, F.wave, 8192, 8192, 16, S, E); }
#endif
        if (l == 0) {
            GSYNC();
            phase_ln(F, 1, ML, MT, F.in[I_LN2G], F.in[I_LN2B], WSP(float, O_X), true, modv + (size_t)3 * 12288, 0, 2048, 8, WSP(const float, O_X) + (size_t)ML * D, modv + 2 * 12288 + 10240, F.in[I_BFC2]);
            GSYNC();
        }
    }
}

extern "C" void kernel_launch(void* const* d_in, const int* in_sizes, int n_in, void* d_out, int out_size, void* d_ws, size_t ws_size, hipStream_t stream) {
    static int grid = 0;
    if (grid == 0) {
        if (n_in != 26 || ws_size < O_END) { fprintf(stderr, "kernel_launch: unexpected n_in %d / ws %zu (need %zu)\n", n_in, ws_size, (size_t)O_END); grid = -1; return; }
        int dev = 0, cus = 0, per_cu = 0;
        hipGetDevice(&dev); hipDeviceGetAttribute(&cus, hipDeviceAttributeMultiprocessorCount, dev);
        hipFuncSetAttribute((const void*)mega_fwd, hipFuncAttributeMaxDynamicSharedMemorySize, LDS_BYTES);
        hipOccupancyMaxActiveBlocksPerMultiprocessor(&per_cu, (const void*)mega_fwd, NTHR, LDS_BYTES);
        if (per_cu < 1) { fprintf(stderr, "kernel_launch: occupancy query says %d blocks per CU\n", per_cu); per_cu = 1; }
        grid = cus;
        (void)hipGetLastError();
    }
    if (grid < 0) return;
    Params p{};
    for (int i = 0; i < 26; ++i) p.in[i] = (const float*)d_in[i];
    p.out = (float*)d_out; p.ws = (unsigned char*)d_ws;
    if (hipMemsetAsync((char*)d_ws + O_BAR, 0, MEMSET_BYTES, stream) != hipSuccess) { fprintf(stderr, "kernel_launch: memset failed\n"); return; }
    void* args[] = {&p};
    hipError_t e = hipLaunchCooperativeKernel((const void*)mega_fwd, dim3(grid), dim3(NTHR), args, LDS_BYTES, stream);
    if (e != hipSuccess) fprintf(stderr, "cooperative launch failed: %s (grid %d)\n", hipGetErrorString(e), grid);
}
```

```cpp
#include <hip/hip_runtime.h>
#include <hip/hip_cooperative_groups.h>
#include <cstdio>
#include <cstdint>
namespace cg = cooperative_groups;
#ifndef REP_PRO
#define REP_PRO 1
#endif
#ifndef REP_ATT
#define REP_ATT 1
#endif
#ifndef REP_ELT
#define REP_ELT 1
#endif
#ifndef REP_INPROJ
#define REP_INPROJ 1
#endif
#ifndef REP_FC1
#define REP_FC1 1
#endif
#ifndef REP_DFTG
#define REP_DFTG 1
#endif
#ifndef REP_PA
#define REP_PA 1
#endif
#ifndef REP_PB
#define REP_PB 1
#endif
#ifndef REP_PC
#define REP_PC 1
#endif
#ifndef REP_PD
#define REP_PD 1
#endif
#ifndef REP_WOUT
#define REP_WOUT 1
#endif
#ifndef REP_FC2
#define REP_FC2 1
#endif
#ifndef REP_SYNC
#define REP_SYNC 1
#endif
#define GSYNC() do { for (int _r = 0; _r < REP_SYNC; ++_r) { XcdBarrier xb_; xb_.bar = (unsigned*)(p.ws + O_BAR); xb_.x = xb_xcc_id(); xb_.st = (volatile LAS unsigned*)(lds + 131072 + 64); xcd_barrier(xb_); } } while (0)

#define LAS __attribute__((address_space(3)))
typedef unsigned short bf16;
typedef short bf16x8 __attribute__((ext_vector_type(8)));
typedef float f32x4 __attribute__((ext_vector_type(4)));
typedef float f32x2 __attribute__((ext_vector_type(2)));
typedef unsigned u32x4 __attribute__((ext_vector_type(4)));
typedef unsigned u32x2 __attribute__((ext_vector_type(2)));

constexpr int D = 2048, ML = 8192, MT = 8704, DFF = 8192, NP1 = 3072;
constexpr float LN_EPS = 1e-5f;
constexpr float ALPHA = 1.41421356237f;
constexpr int NWAVES = 8, NTHR = 512;
constexpr int LDS_BYTES = 147456;

constexpr size_t O_WIN = 0;
constexpr size_t O_WOUT = O_WIN + 41943040;
constexpr size_t O_W1 = O_WOUT + 16777216;
constexpr size_t O_W2 = O_W1 + 67108864;
constexpr size_t O_WG = O_W2 + 67108864;
constexpr size_t O_WF = O_WG + 4194304;
constexpr size_t O_WFOLD = O_WF + 4194304;
constexpr size_t O_DFT = O_WFOLD + 2097152;
constexpr size_t O_DFTC = O_DFT + 67108864;
constexpr size_t O_MODV = O_DFTC + 262144;
constexpr size_t O_X = O_MODV + 294912;
constexpr size_t O_Y = O_X + 71303168;
constexpr size_t O_U = O_Y + 71303168;
constexpr size_t O_MIX = O_U + 35651584;
constexpr size_t O_R = O_MIX + 35651584;
constexpr size_t O_P1 = O_R;
constexpr size_t O_VT = O_P1 + 53477376;
constexpr size_t O_ABT = O_VT + 17825792;
constexpr size_t O_ABTC = O_ABT + 16777216;
constexpr size_t O_QR = O_ABTC + 1048576;
constexpr size_t O_KR = O_QR + 16777216;
constexpr size_t O_XC = O_KR + 17825792;
constexpr size_t O_AA = O_XC + 8912896;
constexpr size_t O_UU = O_AA + 35651584;
constexpr size_t O_PART = O_UU + 35651584;
constexpr size_t O_SUMA = O_PART + 71303168;
constexpr size_t O_SUMB = O_SUMA + 557056;
constexpr size_t O_SPT = O_SUMB + 557056;
constexpr size_t O_CPART = O_SPT + 8192;
constexpr size_t O_BAR = O_CPART + 33554432;
constexpr size_t O_CNT = O_BAR + 16384;
constexpr size_t O_XB = O_CNT + 131072;
constexpr size_t O_END = O_XB + 2 * 524288;
constexpr size_t MEMSET_BYTES = 16384 + 131072;
constexpr size_t O_H = O_R;
static_assert(O_H + 142606336 <= O_END, "H overlay");

struct Params { const float* in[26]; float* out; unsigned char* ws; };
enum { I_X = 0, I_C, I_CTX, I_CCTX, I_WMOD, I_BMOD, I_WIN, I_RPB, I_CONVW, I_CONVB, I_WA, I_BA, I_WX, I_BX, I_LAM, I_FNOW, I_FNOB, I_WOUT, I_LN1G, I_LN1B, I_WFC1, I_BFC1, I_WFC2, I_BFC2, I_LN2G, I_LN2B };

__device__ __forceinline__ int lane_id_fresh() { unsigned m = ~0u; asm volatile("" : "+s"(m)); return (int)__builtin_amdgcn_mbcnt_hi(m, __builtin_amdgcn_mbcnt_lo(m, 0u)); }
__device__ __forceinline__ unsigned pk2(float lo, float hi) { unsigned r; asm volatile("v_cvt_pk_bf16_f32 %0, %1, %2" : "=v"(r) : "v"(lo), "v"(hi)); return r; }
__device__ __forceinline__ float bf2f(unsigned h) { return __uint_as_float(h << 16); }
__device__ __forceinline__ float sigmoidf_(float x) { return 1.0f / (1.0f + __expf(-x)); }
__device__ __forceinline__ float sigmoid_fast(float x) { return __builtin_amdgcn_rcpf(1.0f + __builtin_amdgcn_exp2f(-1.4426950408889634f * x)); }

namespace pg8 {
constexpr int BM = 256, BK = 64, HALF = 128, HTB = HALF * BK * 2, NXCD = 8, WGM = 8;
__device__ __forceinline__ int lds_byte(int r, int c) { const int st = (r >> 4) * 2 + (c >> 5), rr = r & 15, cc = c & 31, ob = rr * 64 + cc * 2; return st * 1024 + (ob ^ (((ob >> 9) & 1) << 5)); }
__device__ __forceinline__ void stage_rc(int b, int& R, int& C) { const int st = b / 1024, sb = b % 1024, swz = sb ^ (((sb >> 9) & 1) << 5); R = (st >> 1) * 16 + swz / 64; C = (st & 1) * 32 + (swz % 64) / 2; }
__device__ __forceinline__ int perm32(int rho) { const int n = rho >> 4, i = rho & 15; return 8 * (i >> 2) + 4 * n + (i & 3); }

struct Unit { const char* a; const char* b; int pm, pn, aux; };

__device__ __forceinline__ void tile_of(int L, int nM, int nN, int& pm, int& pn) {
    const int nwg = nM * nN; int wgid = L;
    { const int q = nwg / NXCD, r = nwg % NXCD, xcd = wgid % NXCD, off = wgid / NXCD; wgid = (xcd < r ? xcd * (q + 1) : r * (q + 1) + (xcd - r) * q) + off; }
    const int nig = WGM * nN, gid = wgid / nig, fm = gid * WGM, gsz = (nM - fm) < WGM ? (nM - fm) : WGM;
    pm = fm + ((wgid % nig) % gsz); pn = (wgid % nig) / gsz;
}

template <class Epi, class Sched>
__device__ __forceinline__ void gemm_phase(LAS unsigned char* lds, const int wave_, const int lda_, const int ldb_, const int nt_, const Sched& S, const Epi& E) {
    int lda = lda_, ldb = ldb_, nt = nt_; asm volatile("" : "+s"(lda), "+s"(ldb), "+s"(nt));
    int lane = lane_id_fresh(); int wid = wave_; asm volatile("" : "+v"(lane), "+s"(wid));
    const int tid = wid * 64 + lane, wr = wid >> 2, wc = wid & 3, fr = lane & 15, fq = lane >> 4;
    unsigned voffA[2], voffB[2];
#pragma unroll
    for (int i = 0; i < 2; ++i) { int R, C; stage_rc(tid * 16 + i * 8192, R, C); const int Rb = Epi::PERM ? ((R & ~31) + perm32(R & 31)) : R;
        voffA[i] = (unsigned)(R * lda + C) * 2u; voffB[i] = (unsigned)(Rb * ldb + C) * 2u; }
    const size_t kstep = (size_t)(BK * 2);
    const size_t hstepA = (size_t)HALF * lda * 2, hstepB = (size_t)HALF * ldb * 2;
    const unsigned ldsw = (unsigned)wid * 1024u;
    const int aoff = lds_byte(wr * 64 + fr, fq * 8), boff = lds_byte(wc * 32 + fr, fq * 8);
#define PG8_SA(b, h) (((b) * 2 + (h)) * HTB)
#define PG8_SB(b, h) ((4 + (b) * 2 + (h)) * HTB)
#define PG8_STAGE(bufoff, gbase, voff) do { _Pragma("unroll") for (int _i = 0; _i < 2; ++_i) \
        __builtin_amdgcn_global_load_lds((const unsigned*)((const char*)(gbase) + (voff)[_i]), (LAS unsigned*)(lds + (bufoff) + ldsw + _i * 8192), 16, 0, 0); } while (0)
#define PG8_LDA(dst, b, h) do { _Pragma("unroll") for (int m = 0; m < 4; ++m) _Pragma("unroll") for (int k = 0; k < 2; ++k) dst[m][k] = *(const LAS bf16x8*)(lds + PG8_SA(b, h) + aoff + m * 2048 + k * 1024); } while (0)
#define PG8_LDB(dst, b, h) do { _Pragma("unroll") for (int n = 0; n < 2; ++n) _Pragma("unroll") for (int k = 0; k < 2; ++k) dst[n][k] = *(const LAS bf16x8*)(lds + PG8_SB(b, h) + boff + n * 2048 + k * 1024); } while (0)
#define PG8_MMA(ai, bj, At, Bt) do { __builtin_amdgcn_s_setprio(1); _Pragma("unroll") for (int m = 0; m < 4; ++m) _Pragma("unroll") for (int n = 0; n < 2; ++n) _Pragma("unroll") for (int k = 0; k < 2; ++k) \
        acc[ai][bj][m][n] = __builtin_amdgcn_mfma_f32_16x16x32_bf16(Bt[n][k], At[m][k], acc[ai][bj][m][n], 0, 0, 0); __builtin_amdgcn_s_setprio(0); } while (0)
#define PG8_WAIT_V(n) asm volatile("s_waitcnt vmcnt(" #n ")" ::: "memory")
#define PG8_WAIT_L(n) asm volatile("s_waitcnt lgkmcnt(" #n ")" ::: "memory")
#define PG8_BAR __builtin_amdgcn_s_barrier()
#define PG8_SCHED __builtin_amdgcn_sched_barrier(0)
    Unit cur, nxt; int ui = 0;
    if (!S.next(0, cur)) return;
    f32x4 acc[2][2][4][2];
#pragma unroll
    for (int a = 0; a < 2; ++a)
#pragma unroll
        for (int b = 0; b < 2; ++b)
#pragma unroll
            for (int m = 0; m < 4; ++m)
#pragma unroll
                for (int n = 0; n < 2; ++n) acc[a][b][m][n] = (f32x4){0.f, 0.f, 0.f, 0.f};
    bf16x8 At[4][2], B0[2][2], B1[2][2];
    const char* cA = cur.a; const char* cB = cur.b;
    PG8_STAGE(PG8_SB(0, 0), cB, voffB); PG8_STAGE(PG8_SB(0, 1), cB + hstepB, voffB); PG8_STAGE(PG8_SA(0, 0), cA, voffA); PG8_STAGE(PG8_SA(0, 1), cA + hstepA, voffA);
    if (wr == 1) PG8_BAR;
    PG8_WAIT_V(2); PG8_BAR;
    PG8_STAGE(PG8_SB(1, 0), cB + kstep, voffB); PG8_STAGE(PG8_SA(1, 0), cA + kstep, voffA); PG8_STAGE(PG8_SB(1, 1), cB + hstepB + kstep, voffB);
    PG8_WAIT_V(6); PG8_BAR;
    for (;;) {
        const bool has_next = S.next(ui + 1, nxt);
        const char* nA = has_next ? nxt.a : cA; const char* nB = has_next ? nxt.b : cB;
        for (int t = 0; t < nt; t += 2) {
            const bool last = (t == nt - 2);
            const char* a1 = cA + (size_t)(t + 1) * kstep;
            const char* a2 = last ? nA : cA + (size_t)(t + 2) * kstep; const char* b2 = last ? nB : cB + (size_t)(t + 2) * kstep;
            const char* a3 = a2 + kstep; const char* b3 = b2 + kstep;
            PG8_LDB(B0, 0, 0); PG8_LDB(B1, 0, 1); PG8_SCHED; PG8_LDA(At, 0, 0); PG8_STAGE(PG8_SA(1, 1), a1 + hstepA, voffA);
            PG8_WAIT_V(8); PG8_WAIT_L(0); PG8_BAR; PG8_MMA(0, 0, At, B0); PG8_MMA(0, 1, At, B1); PG8_BAR; PG8_SCHED;
            PG8_LDA(At, 0, 1); PG8_STAGE(PG8_SB(0, 0), b2, voffB); PG8_STAGE(PG8_SB(0, 1), b2 + hstepB, voffB); PG8_STAGE(PG8_SA(0, 0), a2, voffA);
            PG8_WAIT_V(8); PG8_WAIT_L(0); PG8_BAR; PG8_MMA(1, 0, At, B0); PG8_MMA(1, 1, At, B1); PG8_BAR; PG8_SCHED;
            PG8_LDB(B0, 1, 0); PG8_LDB(B1, 1, 1); PG8_SCHED; PG8_LDA(At, 1, 0); PG8_STAGE(PG8_SA(0, 1), a2 + hstepA, voffA);
            PG8_WAIT_V(8); PG8_WAIT_L(0); PG8_BAR; PG8_MMA(0, 0, At, B0); PG8_MMA(0, 1, At, B1); PG8_BAR; PG8_SCHED;
            PG8_LDA(At, 1, 1); PG8_STAGE(PG8_SB(1, 0), b3, voffB); PG8_STAGE(PG8_SB(1, 1), b3 + hstepB, voffB); PG8_STAGE(PG8_SA(1, 0), a3, voffA);
            PG8_WAIT_V(8); PG8_WAIT_L(0); PG8_BAR; PG8_MMA(1, 0, At, B0); PG8_MMA(1, 1, At, B1); PG8_BAR; PG8_SCHED;
        }
        if (wr == 0) PG8_BAR;
        if constexpr (!Epi::AFTER_DRAIN) { int fr_ = fr, fq_ = fq; asm volatile("" : "+v"(fr_), "+v"(fq_)); E(acc, cur, wr, wc, fr_, fq_); }
        if (!has_next) break;
#pragma unroll
        for (int a = 0; a < 2; ++a)
#pragma unroll
            for (int b = 0; b < 2; ++b)
#pragma unroll
                for (int m = 0; m < 4; ++m)
#pragma unroll
                    for (int n = 0; n < 2; ++n) acc[a][b][m][n] = (f32x4){0.f, 0.f, 0.f, 0.f};
        cur = nxt; cA = nA; cB = nB; ++ui;
        if (wr == 1) PG8_BAR;
    }
    PG8_WAIT_V(0);
    PG8_BAR;
    if constexpr (Epi::AFTER_DRAIN) { int fr_ = fr, fq_ = fq; asm volatile("" : "+v"(fr_), "+v"(fq_)); E.fused(acc, cur, wr, wc, fr_, fq_, lds, wid, lane); }
#undef PG8_SA
#undef PG8_SB
#undef PG8_STAGE
#undef PG8_LDA
#undef PG8_LDB
#undef PG8_MMA
#undef PG8_WAIT_V
#undef PG8_WAIT_L
#undef PG8_BAR
#undef PG8_SCHED
}
}

#define XB_TMO      128
#define XB_XCNT(j)  (256  + 64 * (j))
#define XB_XSUB(j)  (1280 + 64 * (j))
#define XB_XGEN(j)  (2304 + 64 * (j))
#define XB_TOP      3328
#define XB_TOPGEN   3392
#define XCD_BAR_WORDS 3456
#define XB_SPIN_CAP (1u << 22)
__device__ __forceinline__ unsigned xb_ld(unsigned* p)              { return __hip_atomic_load(p, __ATOMIC_RELAXED, __HIP_MEMORY_SCOPE_AGENT); }
__device__ __forceinline__ unsigned xb_add(unsigned* p, unsigned v) { return __hip_atomic_fetch_add(p, v, __ATOMIC_RELAXED, __HIP_MEMORY_SCOPE_AGENT); }
__device__ __forceinline__ unsigned xb_xcc_id() { return (unsigned)__builtin_amdgcn_s_getreg((3 << 11) | 20) & 0xFu; }
#define XB_SPIN(cond, bar) do { unsigned _sp = 0; while (cond) { __builtin_amdgcn_s_sleep(1); \
    if ((++_sp & 255u) == 0u) { if (xb_ld(&(bar)[XB_TMO])) break; if (_sp > XB_SPIN_CAP) { atomicAdd(&(bar)[XB_TMO], 1u); break; } } } } while (0)
struct XcdBarrier { unsigned* bar; unsigned x; volatile LAS unsigned* st; };
__device__ __forceinline__ XcdBarrier xcd_barrier_post(unsigned* bar, volatile LAS unsigned* st) {
    XcdBarrier b; b.bar = bar; b.x = xb_xcc_id(); b.st = st;
    if (threadIdx.x == 0) (void)xb_add(&bar[XB_XCNT(b.x)], 1u);
    return b;
}
__device__ __forceinline__ void xcd_barrier_complete(unsigned* bar, unsigned x, unsigned& nloc, unsigned& nx) {
    const unsigned G = gridDim.x * gridDim.y * gridDim.z;
    unsigned sum, cnt, mine, sp = 0u;
    for (;;) {
        sum = 0u; cnt = 0u; mine = 0u;
#pragma unroll
        for (unsigned j = 0; j < 16; ++j) { const unsigned c = xb_ld(&bar[XB_XCNT(j)]); sum += c; cnt += (c > 0u) ? 1u : 0u; mine = (j == x) ? c : mine; }
        if (sum == G) break;
        __builtin_amdgcn_s_sleep(1);
        if ((++sp & 255u) == 0u) { if (xb_ld(&bar[XB_TMO])) break; if (sp > XB_SPIN_CAP) { atomicAdd(&bar[XB_TMO], 1u); break; } }
    }
    nloc = mine > 0u ? mine : 1u; nx = cnt > 0u ? cnt : 1u;
}
__device__ __forceinline__ void xcd_barrier(const XcdBarrier& b) {
    asm volatile("s_waitcnt vmcnt(0)" ::: "memory");
    __syncthreads();
    if (threadIdx.x == 0) {
        unsigned* bar = b.bar;
        __builtin_amdgcn_s_waitcnt(0);
        unsigned nloc = b.st[0], nx = b.st[1];
        if (nloc == 0u) { xcd_barrier_complete(bar, b.x, nloc, nx); b.st[0] = nloc; b.st[1] = nx; }
        const unsigned old = xb_add(&bar[XB_XSUB(b.x)], 1u);
        const unsigned gen = old / nloc;
        if (old + 1u == (gen + 1u) * nloc) {
            __builtin_amdgcn_fence(__ATOMIC_RELEASE, "agent");
            asm volatile("s_waitcnt vmcnt(0)" ::: "memory");
            const unsigned og = xb_add(&bar[XB_TOP], 1u);
            const unsigned tg = og / nx;
            if (og + 1u == (tg + 1u) * nx) xb_add(&bar[XB_TOPGEN], 1u);
            else XB_SPIN(xb_ld(&bar[XB_TOPGEN]) == tg, bar);
            __builtin_amdgcn_fence(__ATOMIC_ACQUIRE, "agent");
            xb_add(&bar[XB_XGEN(b.x)], 1u);
            asm volatile("s_waitcnt vmcnt(0)" ::: "memory");
        } else {
            XB_SPIN(xb_ld(&bar[XB_XGEN(b.x)]) == gen, bar);
            __builtin_amdgcn_fence(__ATOMIC_ACQUIRE, "agent");
            asm volatile("s_waitcnt vmcnt(0)" ::: "memory");
        }
    }
    __syncthreads();
}

struct Frame {
    const float* const* in;
    unsigned char* ws; float* out;
    int tid, lane, wave, G, bid;
};
#define WSP(T, off) ((T*)(F.ws + (off)))

enum { M_FOLD = 0, M_INPROJ, M_FC1, M_DFT, M_GATES, M_WOUT, M_FC2, M_WOUTC, M_FC2C, M_CDFT };

struct Sched {
    unsigned char* ws; int mode, l, G, c, total;
    __device__ __forceinline__ void init(unsigned char* ws_, int mode_, int l_, int G_, int c_) {
        ws = ws_; mode = mode_; l = l_; G = G_; c = c_;
        const int nM = (l == 0) ? 34 : 32;
        switch (mode) {
            case M_FOLD: total = 64; break;
            case M_INPROJ: total = 34 * 12 + 8 * 34; break;
            case M_FC1: total = nM * 32; break;
            case M_DFT: total = 256; break;
            case M_GATES: total = 272; break;
            case M_CDFT: total = 4; break;
            case M_WOUT: total = 256; break;
            case M_FC2: total = 256; break;
            case M_WOUTC: total = 64; break;
            default: total = 128; break;
        }
    }
    __device__ __forceinline__ bool next(int i, pg8::Unit& u) const {
        int L = i * G + c;
        if (mode == M_CDFT && G == 256) L -= 16;
        if (L < 0 || L >= total) return false;
        const int nM = (l == 0) ? 34 : 32;
        u.aux = 0;
        switch (mode) {
            case M_FOLD: { const int lw = L >> 5, r = L & 31; u.pm = r >> 3; u.pn = r & 7; u.aux = lw;
                u.a = (const char*)(ws + O_WFOLD) + ((size_t)lw * 1024 + u.pm * 256) * 512 * 2; u.b = (const char*)(ws + O_WF) + ((size_t)lw * 2048 + u.pn * 256) * 512 * 2; } break;
            case M_INPROJ: {
                if (L < 408) { pg8::tile_of(L, 34, 12, u.pm, u.pn); u.aux = 0;
                    u.a = (const char*)(ws + O_U) + (size_t)u.pm * 256 * 2048 * 2; u.b = (const char*)(ws + O_WIN) + ((size_t)l * 5120 + u.pn * 256) * 2048 * 2; }
                else { pg8::tile_of(L - 408, 8, 34, u.pm, u.pn); u.aux = 1;
                    u.a = (const char*)(ws + O_WIN) + ((size_t)l * 5120 + 3072 + u.pm * 256) * 2048 * 2; u.b = (const char*)(ws + O_U) + (size_t)u.pn * 256 * 2048 * 2; }
            } break;
            case M_FC1: { pg8::tile_of(L, nM, 32, u.pm, u.pn);
                u.a = (const char*)(ws + O_U) + (size_t)u.pm * 256 * 2048 * 2; u.b = (const char*)(ws + O_W1) + ((size_t)l * 8192 + u.pn * 256) * 2048 * 2; } break;
            case M_DFT: { const int ks = L >> 5, r = L & 31, b = r >> 4, mt = (r & 15) >> 1, pn = r & 1; u.pm = b * 8 + mt; u.pn = pn; u.aux = ks;
                u.a = (const char*)(ws + O_DFT) + ((size_t)mt * 256 * 8192 + ks * 1024) * 2; u.b = (const char*)(ws + O_ABT) + ((size_t)(b * 512 + pn * 256) * 8192 + ks * 1024) * 2; } break;
            case M_GATES: { u.pm = L >> 3; u.pn = L & 7; u.aux = 0; const int blk = u.pn & 3;
                    u.a = (const char*)(ws + O_XC) + ((size_t)u.pm * 256 * 512 + blk * 128) * 2; u.b = (const char*)(ws + O_WG) + (((size_t)l * 2048 + u.pn * 256) * 512 + blk * 128) * 2; } break;
            case M_CDFT: { const int b = L >> 1, pn = L & 1; u.pm = 32 + b; u.pn = pn; u.aux = 1;
                    u.a = (const char*)(ws + O_DFTC); u.b = (const char*)(ws + O_ABTC) + (size_t)(b * 512 + pn * 256) * 512 * 2; } break;
            case M_WOUT: { pg8::tile_of(L, 32, 8, u.pm, u.pn);
                u.a = (const char*)(ws + O_MIX) + (size_t)u.pm * 256 * 2048 * 2; u.b = (const char*)(ws + O_WOUT) + ((size_t)l * 2048 + u.pn * 256) * 2048 * 2; } break;
            case M_FC2: { pg8::tile_of(L, 32, 8, u.pm, u.pn);
                u.a = (const char*)(ws + O_H) + (size_t)u.pm * 256 * 8192 * 2; u.b = (const char*)(ws + O_W2) + ((size_t)l * 2048 + u.pn * 256) * 8192 * 2; } break;
            case M_WOUTC: { const int ks = L >> 4, r = L & 15; u.pm = 32 + (r >> 3); u.pn = r & 7; u.aux = ks;
                u.a = (const char*)(ws + O_MIX) + ((size_t)u.pm * 256 * 2048 + ks * 512) * 2; u.b = (const char*)(ws + O_WOUT) + (((size_t)l * 2048 + u.pn * 256) * 2048 + ks * 512) * 2; } break;
            default: { const int ks = L >> 4, r = L & 15; u.pm = 32 + (r >> 3); u.pn = r & 7; u.aux = ks;
                u.a = (const char*)(ws + O_H) + ((size_t)u.pm * 256 * 8192 + ks * 1024) * 2; u.b = (const char*)(ws + O_W2) + (((size_t)l * 2048 + u.pn * 256) * 8192 + ks * 1024) * 2; } break;
        }
        return true;
    }
};

__device__ __forceinline__ float bperm_f(int byteidx, float v) { return __int_as_float(__builtin_amdgcn_ds_bpermute(byteidx, __float_as_int(v))); }
__device__ __forceinline__ void xpose_f32(const f32x4& v0, const f32x4& v1, f32x4& oA, f32x4& oB, int lane) {
    const int srcA = ((lane >> 3) + 16 * (lane & 3)) * 4, srcB = srcA + 32; const bool hi = (lane >> 2) & 1;
#pragma unroll
    for (int j = 0; j < 4; ++j) { const float a0 = bperm_f(srcA, v0[j]), a1 = bperm_f(srcA, v1[j]), b0 = bperm_f(srcB, v0[j]), b1 = bperm_f(srcB, v1[j]); oA[j] = hi ? a1 : a0; oB[j] = hi ? b1 : b0; }
}
__device__ __forceinline__ u32x4 xpose_b16(const u32x4& w, int lane) {
    const int src = ((lane >> 2) + 16 * (lane & 3)) * 4; u32x4 o;
    o.x = (unsigned)__builtin_amdgcn_ds_bpermute(src, (int)w.x); o.y = (unsigned)__builtin_amdgcn_ds_bpermute(src, (int)w.y); o.z = (unsigned)__builtin_amdgcn_ds_bpermute(src, (int)w.z); o.w = (unsigned)__builtin_amdgcn_ds_bpermute(src, (int)w.w);
    return o;
}

struct EpiB {
    static constexpr bool PERM = true, AFTER_DRAIN = false;
    unsigned char* ws; const float* const* in; int mode, l;
    __device__ __forceinline__ void operator()(const f32x4 (&acc)[2][2][4][2], const pg8::Unit& u, int wr, int wc, int fr, int fq) const {
        bf16* base; size_t ld; const float* bias = nullptr; bool vtb = false;
        if (mode == M_FOLD) { base = (bf16*)(ws + O_WIN) + ((size_t)u.aux * 5120 + 4096 + u.pm * 256) * 2048 + u.pn * 256; ld = 2048; }
        else if (mode == M_FC1) { base = (bf16*)(ws + O_H) + (size_t)u.pm * 256 * 8192 + u.pn * 256; ld = 8192; bias = in[I_BFC1] + (size_t)l * 8192 + u.pn * 256; }
        else {
            if (u.aux == 0) { base = (bf16*)(ws + O_P1) + (size_t)u.pm * 256 * NP1 + u.pn * 256; ld = NP1; }
            else if (u.pm < 4) { base = (bf16*)(ws + O_VT) + (size_t)(u.pn * 4) * 65536 + (size_t)u.pm * 256 * 64; ld = 64; vtb = true; }
            else { const int q = u.pm - 4, part = q >> 1, nb = (q & 1) * 256;
                if (u.pn < 32) { const int bb = u.pn >> 4, t0 = (u.pn & 15) * 256; base = (bf16*)(ws + O_ABT) + ((size_t)(bb * 512 + nb) * 2 + part) * 4096 + t0; ld = 8192; }
                else { const int bb = u.pn - 32; base = (bf16*)(ws + O_ABTC) + ((size_t)(bb * 512 + nb) * 2 + part) * 256; ld = 512; } }
        }
        const int lane = fr + 16 * fq;
        const int row0 = wr * 64 + (lane >> 2), col0 = wc * 32 + 8 * fq, scol0 = wc * 32 + 8 * (lane & 3);
        f32x4 bv[2][2];
#pragma unroll
        for (int bj = 0; bj < 2; ++bj)
#pragma unroll
            for (int n = 0; n < 2; ++n) bv[bj][n] = bias ? *(const f32x4*)(bias + col0 + bj * 128 + 4 * n) : (f32x4){0.f, 0.f, 0.f, 0.f};
#pragma unroll
        for (int ai = 0; ai < 2; ++ai)
#pragma unroll
            for (int m = 0; m < 4; ++m) { bf16* rowp = base + (size_t)(row0 + ai * 128 + m * 16) * ld + (vtb ? (size_t)(scol0 >> 6) * 65536 + (scol0 & 63) : (size_t)scol0);
                const size_t bjs = vtb ? 131072 : 128;
#pragma unroll
                for (int bj = 0; bj < 2; ++bj) { f32x4 v0 = acc[ai][bj][m][0] + bv[bj][0], v1 = acc[ai][bj][m][1] + bv[bj][1];
                    if (mode == M_FC1) {
#pragma unroll
                        for (int j = 0; j < 4; ++j) { const float a = fmaxf(v0[j], 0.f), b = fmaxf(v1[j], 0.f); v0[j] = a * a; v1[j] = b * b; } }
                    u32x4 w; w.x = pk2(v0[0], v0[1]); w.y = pk2(v0[2], v0[3]); w.z = pk2(v1[0], v1[1]); w.w = pk2(v1[2], v1[3]);
                    *(u32x4*)(rowp + bj * bjs) = xpose_b16(w, lane); } }
    }
};

struct EpiF {
    static constexpr bool PERM = false, AFTER_DRAIN = false;
    unsigned char* ws; const float* const* in; int mode, l;
    __device__ __forceinline__ void operator()(const f32x4 (&acc)[2][2][4][2], const pg8::Unit& u, int wr, int wc, int fr, int fq) const {
        const int lane = fr + 16 * fq;
        const int row0 = wr * 64 + fr, col0 = wc * 32 + 4 * fq, srow0 = wr * 64 + (lane >> 3), scol0 = wc * 32 + 4 * (lane & 7);
        if (mode == M_DFT || mode == M_WOUTC || mode == M_FC2C || mode == M_CDFT) {
            const size_t ldp = (mode == M_WOUTC || mode == M_FC2C) ? 2048 : 512;
            float* base = (mode == M_DFT) ? (float*)(ws + O_PART) + ((size_t)u.aux * 4096 + u.pm * 256) * 512 + u.pn * 256
                        : (mode == M_CDFT) ? (float*)(ws + O_PART) + 16777216 + ((size_t)(u.pm - 32) * 256) * 512 + u.pn * 256
                        : (float*)(ws + O_CPART) + ((size_t)u.aux * 512 + (u.pm - 32) * 256) * 2048 + u.pn * 256;
#pragma unroll
            for (int ai = 0; ai < 2; ++ai)
#pragma unroll
                for (int m = 0; m < 4; ++m) { float* rowp = base + (size_t)(srow0 + ai * 128 + m * 16) * ldp + scol0;
#pragma unroll
                    for (int bj = 0; bj < 2; ++bj) { f32x4 oA, oB; xpose_f32(acc[ai][bj][m][0], acc[ai][bj][m][1], oA, oB, lane);
                        if (mode == M_DFT) { bf16* hp = (bf16*)(ws + O_PART) + (rowp - (float*)(ws + O_PART));
                            u32x2 wA, wB; wA.x = pk2(oA[0], oA[1]); wA.y = pk2(oA[2], oA[3]); wB.x = pk2(oB[0], oB[1]); wB.y = pk2(oB[2], oB[3]);
                            *(u32x2*)(hp + bj * 128) = wA; *(u32x2*)(hp + 8 * ldp + bj * 128) = wB; }
                        else { *(f32x4*)(rowp + bj * 128) = oA; *(f32x4*)(rowp + 8 * ldp + bj * 128) = oB; } } }
        } else if (mode == M_GATES) {
            const int d = u.pn >> 2, blk = u.pn & 3;
            const float* ba = in[I_BA] + ((size_t)l * 2 + d) * 512; const float* bx = in[I_BX] + ((size_t)l * 2 + d) * 512; const float* lam = (const float*)(ws + O_SPT) + ((size_t)l * 2 + d) * 512;
            const bf16* xc = (const bf16*)(ws + O_XC);
            unsigned* Ao = (unsigned*)(ws + O_AA) + (size_t)d * MT * 512;
            f32x4 bav[2], bxv[2], sp[2];
#pragma unroll
            for (int n = 0; n < 2; ++n) { const int ch = blk * 128 + col0 + 16 * n; bav[n] = *(const f32x4*)(ba + ch); bxv[n] = *(const f32x4*)(bx + ch); sp[n] = *(const f32x4*)(lam + ch); }
            const int sch = blk * 128 + scol0;
#pragma unroll
            for (int ai = 0; ai < 2; ++ai)
#pragma unroll
                for (int m = 0; m < 4; ++m) {
                    const size_t tok = (size_t)u.pm * 256 + srow0 + ai * 128 + m * 16;
                    const u32x2 xa = __builtin_nontemporal_load((const u32x2*)(xc + tok * 512 + sch)), xb = __builtin_nontemporal_load((const u32x2*)(xc + (tok + 8) * 512 + sch));
                    f32x4 av[2], uv[2];
#pragma unroll
                    for (int n = 0; n < 2; ++n)
#pragma unroll
                        for (int j = 0; j < 4; ++j) {
                            const float r = sigmoid_fast(acc[ai][0][m][n][j] + bav[n][j]);
                            const float ig = sigmoid_fast(acc[ai][1][m][n][j] + bxv[n][j]);
                            const float la = sp[n][j] * r;
                            av[n][j] = la;
                            const float aa = __builtin_amdgcn_exp2f(1.4426950408889634f * la);
                            const float x2 = 2.0f * la;
                            const float ser = -x2 * (1.0f + x2 * (0.5f + x2 * (0.16666667f + x2 * (0.041666668f + x2 * (0.0083333338f + x2 * 0.0013888889f)))));
                            const float om = (x2 > -0.35f) ? ser : 1.0f - aa * aa;
                            uv[n][j] = __builtin_amdgcn_sqrtf(fmaxf(om, 0.f)) * ig;
                        }
                    f32x4 aA, aB, uA, uB; xpose_f32(av[0], av[1], aA, aB, lane); xpose_f32(uv[0], uv[1], uA, uB, lane);
                    uA[0] *= bf2f(xa.x & 0xffffu); uA[1] *= bf2f(xa.x >> 16); uA[2] *= bf2f(xa.y & 0xffffu); uA[3] *= bf2f(xa.y >> 16);
                    uB[0] *= bf2f(xb.x & 0xffffu); uB[1] *= bf2f(xb.x >> 16); uB[2] *= bf2f(xb.y & 0xffffu); uB[3] *= bf2f(xb.y >> 16);
                    u32x4 wA, wB; wA.x = pk2(aA[0], uA[0]); wA.y = pk2(aA[1], uA[1]); wA.z = pk2(aA[2], uA[2]); wA.w = pk2(aA[3], uA[3]);
                    wB.x = pk2(aB[0], uB[0]); wB.y = pk2(aB[1], uB[1]); wB.z = pk2(aB[2], uB[2]); wB.w = pk2(aB[3], uB[3]);
                    *(u32x4*)(Ao + tok * 512 + sch) = wA; *(u32x4*)(Ao + (tok + 8) * 512 + sch) = wB;
                    asm volatile("" ::: "memory");
                }
        } else {
            const int mr = (u.pm < 16) ? 0 : (u.pm < 32 ? 1 : 2);
            const float* gp = (const float*)(ws + O_MODV) + ((size_t)l * 3 + mr) * 12288 + (mode == M_WOUT ? 4096 : 10240) + u.pn * 256;
            const float* bias = (mode == M_FC2) ? in[I_BFC2] + (size_t)l * 2048 + u.pn * 256 : nullptr;
            const float* xs;
            if (mode == M_WOUT && l == 0) xs = (u.pm < 32) ? in[I_X] + (size_t)u.pm * 256 * D : in[I_CTX] + (size_t)(u.pm - 32) * 256 * D;
            else xs = (const float*)(ws + O_X) + (size_t)u.pm * 256 * D;
            xs += u.pn * 256;
            float* yo = (float*)(ws + O_Y) + (size_t)u.pm * 256 * D + u.pn * 256;
            f32x4 gv[2][2], bv[2][2];
#pragma unroll
            for (int bj = 0; bj < 2; ++bj)
#pragma unroll
                for (int n = 0; n < 2; ++n) { gv[bj][n] = *(const f32x4*)(gp + col0 + bj * 128 + n * 16); bv[bj][n] = bias ? *(const f32x4*)(bias + col0 + bj * 128 + n * 16) : (f32x4){0.f, 0.f, 0.f, 0.f}; }
#pragma unroll
            for (int ai = 0; ai < 2; ++ai)
#pragma unroll
                for (int m = 0; m < 4; ++m) { const size_t off = (size_t)(srow0 + ai * 128 + m * 16) * D + scol0;
#pragma unroll
                    for (int bj = 0; bj < 2; ++bj) { f32x4 tA, tB; xpose_f32(gv[bj][0] * (acc[ai][bj][m][0] + bv[bj][0]), gv[bj][1] * (acc[ai][bj][m][1] + bv[bj][1]), tA, tB, lane);
                        const f32x4 xA = *(const f32x4*)(xs + off + bj * 128), xB = *(const f32x4*)(xs + off + 8 * D + bj * 128);
                        *(f32x4*)(yo + off + bj * 128) = xA * ALPHA + tA; *(f32x4*)(yo + off + 8 * D + bj * 128) = xB * ALPHA + tB; }
                    asm volatile("" ::: "memory"); }
        }
    }
};

struct PanelStats {
    unsigned long long* xbuf; unsigned* cnt;
    __device__ __forceinline__ void run(const f32x4 (&v)[2][2][4][2], const pg8::Unit& u, int wr, int wc, LAS unsigned char* lds, int wid, int lane) const {
        LAS f32x2* P = (LAS f32x2*)lds;
        LAS f32x2* S = (LAS f32x2*)(lds + 8192);
        const int rl = lane >> 3, cl = lane & 7;
#pragma unroll
        for (int ai = 0; ai < 2; ++ai)
#pragma unroll
            for (int m = 0; m < 4; ++m)
#pragma unroll
                for (int h = 0; h < 2; ++h) {
                    const f32x4 x0 = v[ai][0][m][h], x1 = v[ai][1][m][h];
                    float s = ((x0[0] + x0[1]) + (x0[2] + x0[3])) + ((x1[0] + x1[1]) + (x1[2] + x1[3]));
                    s += __shfl_xor(s, 1); s += __shfl_xor(s, 2); s += __shfl_xor(s, 4);
                    const float mw = s * (1.0f / 64.0f);
                    const f32x4 d0 = x0 - mw, d1 = x1 - mw;
                    float q = ((d0[0] * d0[0] + d0[1] * d0[1]) + (d0[2] * d0[2] + d0[3] * d0[3])) + ((d1[0] * d1[0] + d1[1] * d1[1]) + (d1[2] * d1[2] + d1[3] * d1[3]));
                    q += __shfl_xor(q, 1); q += __shfl_xor(q, 2); q += __shfl_xor(q, 4);
                    if (cl == 0) P[(ai * 128 + wr * 64 + m * 16 + h * 8 + rl) * 4 + wc] = (f32x2){mw, q};
                }
        asm volatile("s_waitcnt lgkmcnt(0)" ::: "memory"); __builtin_amdgcn_s_barrier(); asm volatile("" ::: "memory");
        const int row = wid * 32 + (lane & 31);
        if (lane < 32) {
            const f32x2 a = P[row * 4 + 0], b = P[row * 4 + 1], c = P[row * 4 + 2], d = P[row * 4 + 3];
            const float mt = (a.x + b.x + c.x + d.x) * 0.25f;
            const float da = a.x - mt, db = b.x - mt, dc = c.x - mt, dd = d.x - mt;
            const float m2 = (a.y + b.y) + (c.y + d.y) + 64.0f * ((da * da + db * db) + (dc * dc + dd * dd));
            __hip_atomic_store(xbuf + ((size_t)(u.pm * 256 + row) * 8 + u.pn), ((unsigned long long)__float_as_uint(m2) << 32) | __float_as_uint(mt), __ATOMIC_RELAXED, __HIP_MEMORY_SCOPE_AGENT);
        }
        asm volatile("s_waitcnt vmcnt(0)" ::: "memory");
        if (lane == 0) __hip_atomic_fetch_add(cnt + 64 * u.pm, 1u, __ATOMIC_RELAXED, __HIP_MEMORY_SCOPE_AGENT);
        if (wid == 0) {
            unsigned sp = 0;
            while ((unsigned)__builtin_amdgcn_readfirstlane(__hip_atomic_load(cnt + 64 * u.pm, __ATOMIC_RELAXED, __HIP_MEMORY_SCOPE_AGENT)) < 64u) { __builtin_amdgcn_s_sleep(2); if (++sp > (1u << 22)) break; }
            __builtin_amdgcn_fence(__ATOMIC_ACQUIRE, "agent");
        }
        asm volatile("s_waitcnt vmcnt(0) lgkmcnt(0)" ::: "memory"); __builtin_amdgcn_s_barrier(); asm volatile("" ::: "memory");
        if (lane < 32) {
            const unsigned long long* slot = xbuf + (size_t)(u.pm * 256 + row) * 8; float mt[8], m2[8]; float ms = 0.f;
#pragma unroll
            for (int t = 0; t < 8; ++t) { const unsigned long long w = __hip_atomic_load(slot + t, __ATOMIC_RELAXED, __HIP_MEMORY_SCOPE_AGENT); mt[t] = __uint_as_float((unsigned)w); m2[t] = __uint_as_float((unsigned)(w >> 32)); ms += mt[t]; }
            const float mean = ms * 0.125f; float q = 0.f;
#pragma unroll
            for (int t = 0; t < 8; ++t) { const float dm = mt[t] - mean; q += m2[t] + 256.0f * dm * dm; }
            S[row] = (f32x2){mean, 1.0f / sqrtf(q * (1.0f / 2048.0f) + LN_EPS)};
        }
        asm volatile("s_waitcnt lgkmcnt(0)" ::: "memory"); __builtin_amdgcn_s_barrier(); asm volatile("" ::: "memory");
    }
};
struct EpiLN {
    static constexpr bool PERM = false, AFTER_DRAIN = true;
    unsigned char* ws; const float* const* in; float* out; int mode, l; int dry;
    __device__ __forceinline__ void operator()(const f32x4 (&)[2][2][4][2], const pg8::Unit&, int, int, int, int) const {}
    __device__ __forceinline__ void fused(f32x4 (&acc)[2][2][4][2], const pg8::Unit& u, int wr, int wc, int fr, int fq, LAS unsigned char* lds, int wid, int lane) const {
        const int col0 = wc * 32 + 4 * fq;
        const int rl = lane >> 3, scol = wc * 32 + 4 * (lane & 7);
        const int mr = (u.pm < 16) ? 0 : 1;
        const float* modl = (const float*)(ws + O_MODV) + ((size_t)l * 3 + mr) * 12288;
        const float* gp = modl + (mode == M_WOUT ? 4096 : 10240) + u.pn * 256;
        const float* bias = (mode == M_FC2) ? in[I_BFC2] + (size_t)l * 2048 + u.pn * 256 : nullptr;
        const float* xs = (mode == M_WOUT && l == 0) ? in[I_X] + (size_t)u.pm * 256 * D : (const float*)(ws + O_X) + (size_t)u.pm * 256 * D;
        xs += u.pn * 256;
        const LAS f32x2* S = (const LAS f32x2*)(lds + 8192);
#pragma unroll
        for (int ai = 0; ai < 2; ++ai)
#pragma unroll
            for (int bj = 0; bj < 2; ++bj) {
                int rw0 = wr * 64 + ai * 128 + rl, sc0 = scol + bj * 128; asm volatile("" : "+v"(rw0), "+v"(sc0));
                f32x4 xv[4][2];
#pragma unroll
                for (int m = 0; m < 4; ++m)
#pragma unroll
                    for (int h = 0; h < 2; ++h) xv[m][h] = __builtin_nontemporal_load((const f32x4*)(xs + (size_t)(rw0 + m * 16 + 8 * h) * D + sc0));
                const f32x4 g0 = *(const f32x4*)(gp + col0 + bj * 128), g1 = *(const f32x4*)(gp + col0 + bj * 128 + 16);
                const f32x4 b0 = bias ? *(const f32x4*)(bias + col0 + bj * 128) : (f32x4){0.f, 0.f, 0.f, 0.f}, b1 = bias ? *(const f32x4*)(bias + col0 + bj * 128 + 16) : (f32x4){0.f, 0.f, 0.f, 0.f};
#pragma unroll
                for (int m = 0; m < 4; ++m) { f32x4 tA, tB; xpose_f32(g0 * (acc[ai][bj][m][0] + b0), g1 * (acc[ai][bj][m][1] + b1), tA, tB, lane);
                    acc[ai][bj][m][0] = xv[m][0] * ALPHA + tA; acc[ai][bj][m][1] = xv[m][1] * ALPHA + tB; }
                asm volatile("" : "+v"(acc[ai][bj][0][0]), "+v"(acc[ai][bj][0][1]), "+v"(acc[ai][bj][1][0]), "+v"(acc[ai][bj][1][1]), "+v"(acc[ai][bj][2][0]), "+v"(acc[ai][bj][2][1]), "+v"(acc[ai][bj][3][0]), "+v"(acc[ai][bj][3][1]) :: "memory");
            }
        const int bank = l * 4 + (mode == M_WOUT ? 0 : 2) + (dry ? 8 : 0);
        PanelStats st1{(unsigned long long*)(ws + O_XB), (unsigned*)(ws + O_CNT) + (size_t)bank * 2048};
        const float* gam = (mode == M_WOUT ? in[I_LN1G] : in[I_LN2G]) + (size_t)l * D + u.pn * 256; const float* bet = (mode == M_WOUT ? in[I_LN1B] : in[I_LN2B]) + (size_t)l * D + u.pn * 256;
        const f32x4 gv0 = *(const f32x4*)(gam + scol), gv1 = *(const f32x4*)(gam + scol + 128), bv0 = *(const f32x4*)(bet + scol), bv1 = *(const f32x4*)(bet + scol + 128);
        st1.run(acc, u, wr, wc, lds, wid, lane);
        const bool last = (mode == M_FC2 && l == 1);
        float* xo = (dry ? (float*)(ws + O_PART) : (last ? out : (float*)(ws + O_X))) + (size_t)u.pm * 256 * D + u.pn * 256;
        {
#pragma unroll
            for (int ai = 0; ai < 2; ++ai)
#pragma unroll
                for (int m = 0; m < 4; ++m) { int rw = wr * 64 + ai * 128 + m * 16 + rl; asm volatile("" : "+v"(rw));
#pragma unroll
                    for (int h = 0; h < 2; ++h) { const f32x2 sr = S[rw + 8 * h];
                        const f32x4 a = (acc[ai][0][m][h] - sr.x) * sr.y * gv0 + bv0, b = (acc[ai][1][m][h] - sr.x) * sr.y * gv1 + bv1; acc[ai][0][m][h] = a; acc[ai][1][m][h] = b;
                        if (last) { __builtin_nontemporal_store(a, (f32x4*)(xo + (size_t)(rw + 8 * h) * D + scol)); __builtin_nontemporal_store(b, (f32x4*)(xo + (size_t)(rw + 8 * h) * D + scol + 128)); } }
                    asm volatile("" ::: "memory"); }
        }
        if (last) return;
        PanelStats st2{(unsigned long long*)(ws + O_XB) + 65536, (unsigned*)(ws + O_CNT) + (size_t)(bank + 1) * 2048};
        const float* modn = (mode == M_WOUT) ? modl : (const float*)(ws + O_MODV) + ((size_t)(l + 1) * 3 + mr) * 12288;
        const float* shp = modn + (mode == M_WOUT ? 6144 : 0) + u.pn * 256; const float* scp = modn + (mode == M_WOUT ? 8192 : 2048) + u.pn * 256;
        const f32x4 sh0 = *(const f32x4*)(shp + scol), sh1 = *(const f32x4*)(shp + scol + 128), sc0 = *(const f32x4*)(scp + scol) + 1.0f, sc1 = *(const f32x4*)(scp + scol + 128) + 1.0f;
        st2.run(acc, u, wr, wc, lds, wid, lane);
        bf16* uo = (bf16*)(ws + (dry ? O_Y : O_U)) + (size_t)u.pm * 256 * D + u.pn * 256;
        {
#pragma unroll
            for (int ai = 0; ai < 2; ++ai)
#pragma unroll
                for (int m = 0; m < 4; ++m) { int rw = wr * 64 + ai * 128 + m * 16 + rl; asm volatile("" : "+v"(rw));
#pragma unroll
                    for (int h = 0; h < 2; ++h) { const f32x2 sr = S[rw + 8 * h];
                        *(f32x4*)(xo + (size_t)(rw + 8 * h) * D + scol) = acc[ai][0][m][h]; *(f32x4*)(xo + (size_t)(rw + 8 * h) * D + scol + 128) = acc[ai][1][m][h];
                        const f32x4 a = (acc[ai][0][m][h] - sr.x) * sr.y * sc0 + sh0, b = (acc[ai][1][m][h] - sr.x) * sr.y * sc1 + sh1;
                        u32x2 wa, wb; wa.x = pk2(a[0], a[1]); wa.y = pk2(a[2], a[3]); wb.x = pk2(b[0], b[1]); wb.y = pk2(b[2], b[3]);
                        *(u32x2*)(uo + (size_t)(rw + 8 * h) * D + scol) = wa; *(u32x2*)(uo + (size_t)(rw + 8 * h) * D + scol + 128) = wb; }
                    asm volatile("" ::: "memory"); }
        }
    }
};

__device__ __forceinline__ float wave_sum(float v) {
#pragma unroll
    for (int o = 1; o < 64; o <<= 1) v += __shfl_xor(v, o);
    return v;
}

__device__ __forceinline__ void transpose_item(const float* W, int ldw, int Kd, bf16* WT, LAS float* scr, int k0, int n0s, int n0d, int lane) {
    float tv[32];
#pragma unroll
    for (int i = 0; i < 32; ++i) tv[i] = __builtin_nontemporal_load(&W[(size_t)(k0 + 2 * i + (lane >> 5)) * ldw + n0s + (lane & 31)]);
#pragma unroll
    for (int i = 0; i < 32; ++i) scr[(2 * i + (lane >> 5)) * 33 + (lane & 31)] = tv[i];
    asm volatile("s_waitcnt lgkmcnt(0)" ::: "memory");
    const int c = lane & 7;
#pragma unroll
    for (int j = 0; j < 4; ++j) { const int n = (lane >> 3) + 8 * j; const LAS float* s = scr + (8 * c) * 33 + n;
        u32x4 o; o.x = pk2(s[0 * 33], s[1 * 33]); o.y = pk2(s[2 * 33], s[3 * 33]); o.z = pk2(s[4 * 33], s[5 * 33]); o.w = pk2(s[6 * 33], s[7 * 33]);
        *(u32x4*)(WT + (size_t)(n0d + n) * Kd + k0 + 8 * c) = o; }
    asm volatile("s_waitcnt lgkmcnt(0)" ::: "memory");
}

constexpr int CONV_IA = 32 * 128, CONV_IB = 32 * 64, CONV_IC1 = 32 * 256, CONV_IC2 = 128 * 64, CONV_PER = CONV_IA + CONV_IB + CONV_IC1 + CONV_IC2;
__device__ __forceinline__ void convert_items(const Frame& F, LAS unsigned char* lds, int first, int stride, int base, int end) {
    LAS float* scr = (LAS float*)(lds + 40960 + F.wave * 8448);
    for (int it = base + first; it < end; it += stride) { const int lw = it / CONV_PER; int r = it % CONV_PER;
        if (r < CONV_IA) { const int kb = r >> 7, nb = r & 127, sc = nb * 32; const int dst = sc < 2048 ? sc : (sc < 3072 ? 3072 + (sc - 2048) : 2048 + (sc - 3072));
            transpose_item(F.in[I_WIN] + (size_t)lw * 2048 * 4608, 4608, 2048, WSP(bf16, O_WIN) + (size_t)lw * 5120 * 2048, scr, kb * 64, sc, dst, F.lane); continue; }
        r -= CONV_IA;
        if (r < CONV_IB) { const int kb = r >> 6, nb = r & 63; transpose_item(F.in[I_WOUT] + (size_t)lw * 2048 * 2048, 2048, 2048, WSP(bf16, O_WOUT) + (size_t)lw * 2048 * 2048, scr, kb * 64, nb * 32, nb * 32, F.lane); continue; }
        r -= CONV_IB;
        if (r < CONV_IC1) { const int kb = r >> 8, nb = r & 255; transpose_item(F.in[I_WFC1] + (size_t)lw * 2048 * 8192, 8192, 2048, WSP(bf16, O_W1) + (size_t)lw * 8192 * 2048, scr, kb * 64, nb * 32, nb * 32, F.lane); continue; }
        r -= CONV_IC1;
        { const int kb = r >> 6, nb = r & 63; transpose_item(F.in[I_WFC2] + (size_t)lw * 8192 * 2048, 2048, 8192, WSP(bf16, O_W2) + (size_t)lw * 2048 * 8192, scr, kb * 64, nb * 32, nb * 32, F.lane); }
    }
}

__device__ __forceinline__ void phase_prologue(const Frame& F_, LAS unsigned char* lds) {
    Frame F = F_; F.lane = lane_id_fresh(); asm volatile("" : "+v"(F.lane), "+s"(F.wave)); F.tid = F.wave * 64 + F.lane;
    LAS f32x2* tabL = (LAS f32x2*)lds;
    LAS f32x2* tabC = (LAS f32x2*)(lds + 32768);
    for (int q = F.tid; q < 4096; q += NTHR) { float s, c; sincospif((float)q * (1.0f / 2048.0f), &s, &c); tabL[q] = (f32x2){c, s}; }
    if (F.tid < 128) { float s, c; sincospif((float)F.tid * (1.0f / 64.0f), &s, &c); tabC[F.tid] = (f32x2){c, s}; }
    __syncthreads();
    { LAS float* sc = (LAS float*)(lds + 40960);
      LAS float* red = (LAS float*)(lds + 40960 + 24576);
      for (int i = F.tid; i < 3 * 2048; i += NTHR) { const int r = i >> 11, k = i & 2047; const float v = (r < 2) ? F.in[I_C][r * 2048 + k] : F.in[I_CCTX][k]; sc[i] = v * sigmoidf_(v); }
      __syncthreads();
      for (int _r = 0; _r < REP_PD; ++_r) for (int strip = F.bid; strip < 256; strip += F.G) {
          const int lw = strip >> 7, n0 = (strip & 127) * 96;
          if (F.tid < 384) { const int cl = F.tid % 24, rg = F.tid / 24; const float* w = F.in[I_WMOD] + ((size_t)lw * 2048 + rg * 128) * 12288 + n0 + cl * 4;
              f32x4 a0 = (f32x4){0.f, 0.f, 0.f, 0.f}, a1 = a0, a2 = a0;
#pragma unroll 16
              for (int k = 0; k < 128; ++k) { const f32x4 wv = __builtin_nontemporal_load((const f32x4*)(w + (size_t)k * 12288)); const int kk = rg * 128 + k;
                  a0 += wv * sc[kk]; a1 += wv * sc[2048 + kk]; a2 += wv * sc[4096 + kk]; }
#pragma unroll
              for (int j = 0; j < 4; ++j) { red[(rg * 3 + 0) * 96 + cl * 4 + j] = a0[j]; red[(rg * 3 + 1) * 96 + cl * 4 + j] = a1[j]; red[(rg * 3 + 2) * 96 + cl * 4 + j] = a2[j]; } }
          __syncthreads();
          if (F.tid < 288) { const int r = F.tid / 96, cidx = F.tid % 96; float s = F.in[I_BMOD][(size_t)lw * 12288 + n0 + cidx];
              for (int rg = 0; rg < 16; ++rg) s += red[(rg * 3 + r) * 96 + cidx];
              WSP(float, O_MODV)[((size_t)lw * 3 + r) * 12288 + n0 + cidx] = s; }
          __syncthreads();
      } }
    const int gt = F.bid * NTHR + F.tid, NGT = F.G * NTHR;
    for (int _r = 0; _r < REP_PA; ++_r) { const float sc = 0.00138106793f;
      bf16* Dm = WSP(bf16, O_DFT);
      for (int it = gt; it < 2048 * 1024; it += NGT) { const int k = it >> 10, ch = it & 1023, part = ch >> 9, t0 = (ch & 511) * 8;
          float v[8];
#pragma unroll
          for (int j = 0; j < 8; ++j) { const f32x2 cs = tabL[(k * (t0 + j)) & 4095]; v[j] = part ? -cs.y * sc : cs.x * sc; }
          u32x4 o; o.x = pk2(v[0], v[1]); o.y = pk2(v[2], v[3]); o.z = pk2(v[4], v[5]); o.w = pk2(v[6], v[7]);
          *(u32x4*)(Dm + (size_t)k * 8192 + ch * 8) = o; }
      const float scc = 0.00552427173f;
      bf16* Dc = WSP(bf16, O_DFTC);
      for (int it = gt; it < 256 * 64; it += NGT) { const int k = it >> 6, ch = it & 63, part = ch >> 5, t0 = (ch & 31) * 8;
          float v[8];
#pragma unroll
          for (int j = 0; j < 8; ++j) { const f32x2 cs = tabL[((k * (t0 + j)) & 255) * 16]; v[j] = part ? -cs.y * scc : cs.x * scc; }
          u32x4 o; o.x = pk2(v[0], v[1]); o.y = pk2(v[2], v[3]); o.z = pk2(v[4], v[5]); o.w = pk2(v[6], v[7]);
          *(u32x4*)(Dc + (size_t)k * 512 + ch * 8) = o; } }
    for (int _r = 0; _r < REP_PB; ++_r) { bf16* Wf = WSP(bf16, O_WFOLD);
      for (int it = gt; it < 2 * 1024 * 512; it += NGT) { const int jj = it & 511, np = (it >> 9) & 1023, lw = it >> 19; const int part = np >> 9, nout = np & 511, g = jj >> 7, c = jj & 127;
          const float* fw = F.in[I_FNOW] + ((size_t)lw * 512 + g * 128) * 512 + nout; float s = 0.f;
          for (int m = 0; m < 128; ++m) { const f32x2 cs = tabC[(m * c) & 127]; s += (part ? cs.y : cs.x) * fw[(size_t)m * 512]; }
          Wf[it] = (bf16)(pk2(s, 0.f) & 0xffffu); } }
    for (int it = gt; it < 2048; it += NGT) WSP(float, O_SPT)[it] = -8.0f * log1pf(expf(-F.in[I_LAM][it]));
    { bf16* Wg = WSP(bf16, O_WG);
      for (int it = gt; it < 2 * 2048 * 64; it += NGT) { const int kc = it & 63, n = (it >> 6) & 2047, lw = it >> 17; const int pn = n >> 8, half = (n >> 7) & 1, cc = n & 127, d = pn >> 2, blk = pn & 3, k0 = kc * 8;
          u32x4 o = (u32x4){0u, 0u, 0u, 0u};
          if ((k0 >> 7) == blk) { const float* w = (half ? F.in[I_WX] : F.in[I_WA]) + ((((size_t)lw * 2 + d) * 4 + blk) * 128 + (k0 & 127)) * 128 + cc;
              o.x = pk2(w[0], w[128]); o.y = pk2(w[256], w[384]); o.z = pk2(w[512], w[640]); o.w = pk2(w[768], w[896]); }
          *(u32x4*)(Wg + (size_t)it * 8) = o; } }
    { bf16* Wf = WSP(bf16, O_WF);
      for (int it = gt; it < 2 * 2048 * 64; it += NGT) { const int jc = it & 63, kd = (it >> 6) & 2047, lw = it >> 17;
          const float* w = F.in[I_WIN] + ((size_t)lw * 2048 + kd) * 4608 + 4096 + jc * 8; const f32x4 a = *(const f32x4*)w, b = *(const f32x4*)(w + 4);
          u32x4 o; o.x = pk2(a[0], a[1]); o.y = pk2(a[2], a[3]); o.z = pk2(b[0], b[1]); o.w = pk2(b[2], b[3]);
          *(u32x4*)(Wf + (size_t)it * 8) = o; } }
    for (int _r = 0; _r < REP_PC; ++_r) convert_items(F, lds, F.bid * NWAVES + F.wave, F.G * NWAVES, 0, CONV_IA);
    if (F.G != 256) convert_items(F, lds, F.bid * NWAVES + F.wave, F.G * NWAVES, CONV_IA, 2 * CONV_PER);

}

__device__ __forceinline__ void ln_stats(const f32x4 (&v)[8], float& mean, float& rstd) {
    float s = 0.f;
#pragma unroll
    for (int j = 0; j < 8; ++j) s += (v[j][0] + v[j][1]) + (v[j][2] + v[j][3]);
    mean = wave_sum(s) * (1.0f / D); float q = 0.f;
#pragma unroll
    for (int j = 0; j < 8; ++j) { const f32x4 d = v[j] - mean; q += (d[0] * d[0] + d[1] * d[1]) + (d[2] * d[2] + d[3] * d[3]); }
    rstd = 1.0f / sqrtf(wave_sum(q) * (1.0f / D) + LN_EPS);
}
__device__ __forceinline__ void phase_ln(const Frame& F_, int kind, int row_begin, int nrows, const float* gw_, const float* bw_, float* xdst, bool do_u, const float* modl, int sh_off, int sc_off, int cparts = 0, const float* cres = nullptr, const float* cgate = nullptr, const float* cbias = nullptr) {
    Frame F = F_; F.lane = lane_id_fresh(); asm volatile("" : "+v"(F.lane), "+s"(F.wave)); F.tid = F.wave * 64 + F.lane;
    int gw = F.bid * NWAVES + F.wave, NGW = F.G * NWAVES;
    if (kind == 0 && F.G == 256) { if (F.bid < 64) return; gw -= 64 * NWAVES; NGW -= 64 * NWAVES; }
    for (int m = row_begin + gw; m < nrows; m += NGW) {
        const float* src;
        if (kind == 0) src = (m < ML) ? F.in[I_X] + (size_t)m * D : F.in[I_CTX] + (size_t)(m - ML) * D;
        else src = WSP(const float, O_Y) + (size_t)m * D;
        f32x4 v[8];
        if (cparts > 0 && m >= ML) {
            const float* cp = WSP(const float, O_CPART) + (size_t)(m - ML) * D; const float* rs = cres + (size_t)(m - ML) * D;
#pragma unroll
            for (int j = 0; j < 8; ++j) v[j] = cbias ? *(const f32x4*)(cbias + j * 256 + F.lane * 4) : (f32x4){0.f, 0.f, 0.f, 0.f};
#pragma unroll 1
            for (int ks = 0; ks < cparts; ks += 2) {
                f32x4 p0[8], p1[8];
#pragma unroll
                for (int j = 0; j < 8; ++j) { p0[j] = __builtin_nontemporal_load((const f32x4*)(cp + (size_t)ks * 512 * D + j * 256 + F.lane * 4)); p1[j] = __builtin_nontemporal_load((const f32x4*)(cp + (size_t)(ks + 1) * 512 * D + j * 256 + F.lane * 4)); }
#pragma unroll
                for (int j = 0; j < 8; ++j) v[j] += p0[j] + p1[j];
                asm volatile("" ::: "memory"); }
#pragma unroll
            for (int j = 0; j < 8; ++j) { const int co = j * 256 + F.lane * 4; v[j] = *(const f32x4*)(rs + co) * ALPHA + *(const f32x4*)(cgate + co) * v[j]; }
        } else {
#pragma unroll
        for (int j = 0; j < 8; ++j) v[j] = __builtin_nontemporal_load((const f32x4*)(src + j * 256 + F.lane * 4));
        }
        float mean, rstd;
        if (kind == 1) {
            ln_stats(v, mean, rstd);
#pragma unroll
            for (int j = 0; j < 8; ++j) { const f32x4 g = *(const f32x4*)(gw_ + j * 256 + F.lane * 4), b = *(const f32x4*)(bw_ + j * 256 + F.lane * 4);
                v[j] = (v[j] - mean) * rstd * g + b; *(f32x4*)(xdst + (size_t)m * D + j * 256 + F.lane * 4) = v[j]; }
        }
        if (do_u) {
            ln_stats(v, mean, rstd);
            const int mr = (m < 4096) ? 0 : (m < ML ? 1 : 2);
            const float* mp = modl + (size_t)mr * 12288;
            bf16* up = WSP(bf16, O_U) + (size_t)m * D;
#pragma unroll
            for (int j = 0; j < 8; ++j) { const f32x4 sh = *(const f32x4*)(mp + sh_off + j * 256 + F.lane * 4), sc = *(const f32x4*)(mp + sc_off + j * 256 + F.lane * 4);
                const f32x4 o = (v[j] - mean) * rstd * (sc + 1.0f) + sh; u32x2 w; w.x = pk2(o[0], o[1]); w.y = pk2(o[2], o[3]);
                *(u32x2*)(up + j * 256 + F.lane * 4) = w; }
        }
    }
}

__device__ __forceinline__ void phase_rope_conv(const Frame& F_, int l, LAS unsigned char* lds) {
    Frame F = F_; F.lane = lane_id_fresh(); asm volatile("" : "+v"(F.lane), "+s"(F.wave)); F.tid = F.wave * 64 + F.lane;
    LAS f32x2* tab = (LAS f32x2*)lds;
    for (int i = F.tid; i < 2048; i += NTHR) { const int pos = i >> 5, ii = i & 31; const float inv = powf(10000.0f, -(float)ii * (1.0f / 32.0f)); const float ang = (float)pos * inv; tab[i] = (f32x2){cosf(ang), sinf(ang)}; }
    __syncthreads();
    const int gt = F.bid * NTHR + F.tid, NGT = F.G * NTHR;
    const bf16* P1 = WSP(const bf16, O_P1);
    for (int it0 = gt; it0 < ML * 128; it0 += 4 * NGT) {
        u32x4 av[4], bv[4];
#pragma unroll
        for (int q = 0; q < 4; ++q) { const int it = it0 + q * NGT; if (it < ML * 128) { const int ig = it & 3, half = (it >> 2) & 1, h = (it >> 3) & 7, qk = (it >> 6) & 1, tok = it >> 7;
            const bf16* src = P1 + (size_t)tok * NP1 + qk * 1024 + h * 128 + half * 64 + ig * 8; av[q] = __builtin_nontemporal_load((const u32x4*)src); bv[q] = __builtin_nontemporal_load((const u32x4*)(src + 32)); } }
#pragma unroll
        for (int q = 0; q < 4; ++q) { const int it = it0 + q * NGT; if (it < ML * 128) { const int ig = it & 3, half = (it >> 2) & 1, h = (it >> 3) & 7, qk = (it >> 6) & 1, tok = it >> 7;
            const int t = tok & 4095, pos = half ? (t & 63) : (t >> 6);
            const unsigned aw[4] = {av[q].x, av[q].y, av[q].z, av[q].w}, bw[4] = {bv[q].x, bv[q].y, bv[q].z, bv[q].w};
            float o1[8], o2[8];
#pragma unroll
            for (int j = 0; j < 8; ++j) { const float x1 = bf2f((aw[j >> 1] >> ((j & 1) * 16)) & 0xffffu), x2 = bf2f((bw[j >> 1] >> ((j & 1) * 16)) & 0xffffu);
                const f32x2 cs = tab[pos * 32 + ig * 8 + j]; o1[j] = x1 * cs.x - x2 * cs.y; o2[j] = x1 * cs.y + x2 * cs.x; }
            bf16* dst = qk ? WSP(bf16, O_KR) + ((size_t)h * MT + tok) * 128 + half * 64 + ig * 8 : WSP(bf16, O_QR) + (size_t)tok * 1024 + h * 128 + half * 64 + ig * 8;
            u32x4 w1, w2; w1.x = pk2(o1[0], o1[1]); w1.y = pk2(o1[2], o1[3]); w1.z = pk2(o1[4], o1[5]); w1.w = pk2(o1[6], o1[7]);
            w2.x = pk2(o2[0], o2[1]); w2.y = pk2(o2[2], o2[3]); w2.z = pk2(o2[4], o2[5]); w2.w = pk2(o2[6], o2[7]);
            *(u32x4*)dst = w1; *(u32x4*)(dst + 32) = w2; } }
    }
    for (int it = gt; it < 512 * 128; it += NGT) { const int c8 = it & 15, h = (it >> 4) & 7, tok = ML + (it >> 7);
        *(u32x4*)(WSP(bf16, O_KR) + ((size_t)h * MT + tok) * 128 + c8 * 8) = *(const u32x4*)(P1 + (size_t)tok * NP1 + 1024 + h * 128 + c8 * 8); }
    const float* cw = F.in[I_CONVW] + (size_t)l * 4 * 512; const float* cb = F.in[I_CONVB] + (size_t)l * 512;
    for (int it = gt; it < MT * 64; it += NGT) { const int c8 = it & 63, m = it >> 6;
        int pos, len; if (m < ML) { pos = m & 4095; len = 4096; } else { pos = (m - ML) & 255; len = 256; }
        float acc[8];
        { const f32x4 b0 = *(const f32x4*)(cb + c8 * 8), b1 = *(const f32x4*)(cb + c8 * 8 + 4);
#pragma unroll
          for (int j = 0; j < 4; ++j) { acc[j] = b0[j]; acc[4 + j] = b1[j]; } }
#pragma unroll
        for (int jj = 0; jj < 4; ++jj) { const int p = pos + jj - 2; if (p < 0 || p >= len) continue;
            const u32x4 xv = *(const u32x4*)(P1 + (size_t)(m + jj - 2) * NP1 + 2048 + c8 * 8); const unsigned xw[4] = {xv.x, xv.y, xv.z, xv.w};
            const f32x4 w0 = *(const f32x4*)(cw + jj * 512 + c8 * 8), w1 = *(const f32x4*)(cw + jj * 512 + c8 * 8 + 4);
#pragma unroll
            for (int j = 0; j < 8; ++j) { const float x = bf2f((xw[j >> 1] >> ((j & 1) * 16)) & 0xffffu); acc[j] += x * (j < 4 ? w0[j & 3] : w1[j & 3]); } }
        u32x4 o; o.x = pk2(acc[0], acc[1]); o.y = pk2(acc[2], acc[3]); o.z = pk2(acc[4], acc[5]); o.w = pk2(acc[6], acc[7]);
        *(u32x4*)(WSP(bf16, O_XC) + (size_t)m * 512 + c8 * 8) = o; }
}

constexpr float ATT_SCALE = 0.08838834764831845f, LOG2E = 1.4426950408889634f;
struct AttTile { bf16x8 k[8]; bf16x8 v[8]; };
__device__ __forceinline__ void att_offsets(unsigned (&koff)[2], unsigned (&voff)[2], int lane, int w) {
#pragma unroll
    for (int ii = 0; ii < 2; ++ii) { const int key = 8 * w + 4 * ii + (lane >> 4), sw = (((key >> 3) & 3) << 2) | (key & 3), chunk = (lane & 15) ^ sw; koff[ii] = (unsigned)(key * 128 + chunk * 8) * 2u;
        const int d = 16 * w + 8 * ii + (lane >> 3), cc = (lane & 7) ^ ((d >> 1) & 7); voff[ii] = (unsigned)(d * 64 + cc * 8) * 2u; }
}
__device__ __forceinline__ void att_issue(LAS unsigned char* buf, int w, const bf16* krow, const bf16* vrow, const unsigned (&koff)[2], const unsigned (&voff)[2]) {
#pragma unroll
    for (int ii = 0; ii < 2; ++ii) __builtin_amdgcn_global_load_lds((const unsigned*)((const char*)krow + koff[ii]), (LAS unsigned*)(buf + (2 * w + ii) * 1024), 16, 0, 0);
#pragma unroll
    for (int ii = 0; ii < 2; ++ii) __builtin_amdgcn_global_load_lds((const unsigned*)((const char*)vrow + voff[ii]), (LAS unsigned*)(buf + 16384 + (2 * w + ii) * 1024), 16, 0, 0);
}
__device__ __forceinline__ void att_fetch(AttTile& t, const LAS unsigned char* buf, int cb, int ql, int g, int km) {
#pragma unroll
    for (int s = 0; s < 4; ++s)
#pragma unroll
        for (int sub = 0; sub < 2; ++sub) { const int key = cb + km + 4 * sub, sw = (((key >> 3) & 3) << 2) | (key & 3);
            t.k[2 * s + sub] = *(const LAS bf16x8*)(buf + (key * 16 + ((4 * s + g) ^ sw)) * 16); }
#pragma unroll
    for (int dt = 0; dt < 8; ++dt) { const int d = 16 * dt + ql; t.v[dt] = *(const LAS bf16x8*)(buf + 16384 + (d * 8 + (((cb >> 3) + g) ^ ((d >> 1) & 7))) * 16); }
}
template <bool BAND>
__device__ __forceinline__ void att_compute(const AttTile& t, const bf16x8 (&q)[4], f32x4 (&o)[8], float& mrun, float& lsum, const LAS float* rpr, int kc0, int qc, int cs) {
    f32x4 s0 = (f32x4){0.f, 0.f, 0.f, 0.f}, s1 = s0;
#pragma unroll
    for (int s = 0; s < 4; ++s) { s0 = __builtin_amdgcn_mfma_f32_16x16x32_bf16(t.k[2 * s], q[s], s0, 0, 0, 0); s1 = __builtin_amdgcn_mfma_f32_16x16x32_bf16(t.k[2 * s + 1], q[s], s1, 0, 0, 0); }
    if (BAND) {
        float ba[4], bb[4];
#pragma unroll
        for (int i = 0; i < 4; ++i) { const int ka = kc0 + i, kb = ka + 4; ba[i] = rpr[min(max(ka - qc + 15, 0), 30)]; bb[i] = rpr[min(max(kb - qc + 15, 0), 30)]; }
#pragma unroll
        for (int i = 0; i < 4; ++i) { const int ka = kc0 + i, kb = ka + 4;
            const bool va = (ka >= cs) && (ka < cs + 16), vb = (kb >= cs) && (kb < cs + 16);
            s0[i] = va ? s0[i] * ATT_SCALE + ba[i] : -1e30f; s1[i] = vb ? s1[i] * ATT_SCALE + bb[i] : -1e30f; }
    } else { s0 = s0 * ATT_SCALE; s1 = s1 * ATT_SCALE; }
    float tmax = fmaxf(fmaxf(fmaxf(s0[0], s0[1]), fmaxf(s0[2], s0[3])), fmaxf(fmaxf(s1[0], s1[1]), fmaxf(s1[2], s1[3])));
    tmax = fmaxf(tmax, __shfl_xor(tmax, 16)); tmax = fmaxf(tmax, __shfl_xor(tmax, 32));
    const float mnew = fmaxf(mrun, tmax); const bool grew = __builtin_amdgcn_ballot_w64(mnew > mrun) != 0ull;
    const float corr = __builtin_amdgcn_exp2f((mrun - mnew) * LOG2E); mrun = mnew;
    const float ml = mnew * LOG2E;
    float p0[4], p1[4], ps = 0.f;
#pragma unroll
    for (int i = 0; i < 4; ++i) { p0[i] = (s0[i] > -1e29f) ? __builtin_amdgcn_exp2f(s0[i] * LOG2E - ml) : 0.f; p1[i] = (s1[i] > -1e29f) ? __builtin_amdgcn_exp2f(s1[i] * LOG2E - ml) : 0.f; ps += p0[i] + p1[i]; }
    lsum = lsum * corr + ps;
    if (grew) {
#pragma unroll
        for (int dt = 0; dt < 8; ++dt) o[dt] = o[dt] * corr;
    }
    union { u32x4 u; bf16x8 v; } pb; pb.u.x = pk2(p0[0], p0[1]); pb.u.y = pk2(p0[2], p0[3]); pb.u.z = pk2(p1[0], p1[1]); pb.u.w = pk2(p1[2], p1[3]);
#pragma unroll
    for (int dt = 0; dt < 8; ++dt) o[dt] = __builtin_amdgcn_mfma_f32_16x16x32_bf16(t.v[dt], pb.v, o[dt], 0, 0, 0);
}
__device__ __forceinline__ void phase_attention(const Frame& F_, int l, LAS unsigned char* lds) {
    Frame F = F_; F.lane = lane_id_fresh(); asm volatile("" : "+v"(F.lane), "+s"(F.wave)); F.tid = F.wave * 64 + F.lane;
    const int ql = F.lane & 15, g = F.lane >> 4, km = 8 * (ql >> 2) + (ql & 3);
    const int w = F.wave, wg = w & 3, rsel = w >> 2;
    const bf16* P1 = WSP(const bf16, O_P1); const bf16* QR = WSP(const bf16, O_QR); const bf16* KR = WSP(const bf16, O_KR); const bf16* VT = WSP(const bf16, O_VT);
    LAS float* tabB = (LAS float*)(lds + 131072 + 1024);
    for (int i = F.tid; i < 8 * 465; i += NTHR) tabB[i] = F.in[I_RPB][(size_t)l * 8 * 465 + i];
    __syncthreads();
    unsigned koff[2], voff[2]; att_offsets(koff, voff, F.lane, w);
    const int nbt = 512 + (l == 0 ? 32 : 0);
    for (int bi = 0; ; ++bi) {
        int bt = F.bid + bi * F.G;
        if (F.G == 256 && bi == 2) bt = (l == 0 && F.bid >= 32 && F.bid < 64) ? 512 + (F.bid - 32) : nbt;
        if (bt >= nbt) break;
        const bool lat = bt < 512;
        int b, h, tq, r = 0, r0 = 0, qc = 0;
        if (lat) { const int B = bt & 255, x = B & 7, slot = B >> 3; b = bt >> 8; h = x; r0 = 2 * slot; r = r0 + rsel; qc = 16 * wg + ql; tq = b * 4096 + r * 64 + qc; }
        else { const int q = bt - 512; b = q >> 4; h = (q >> 1) & 7; tq = ML + b * 256 + (q & 1) * 128 + w * 16 + ql; }
        const int cb = (wg == 0) ? 0 : (wg == 1 ? 8 : (wg == 2 ? 24 : 32));
        const int rs0 = min(max(r0 - 4, 0), 56), rs = min(max(r - 4, 0), 56), cs = min(max(qc - 8, 0), 48);
        const LAS float* rp = tabB + h * 465;
        const unsigned kband = (unsigned)((h * MT + b * 4096) * 128);
        const unsigned kctx = (unsigned)((h * MT + ML + b * 256) * 128);
        const unsigned vband = (unsigned)((b * 64) * 65536 + h * 8192);
        const unsigned vctx = (unsigned)((128 + b * 4) * 65536 + h * 8192);
        const int s0 = lat ? 0 : 9, nst = 13;
#define ATT_ISSUE(S) do { const int S_ = min((S), nst - 1); LAS unsigned char* bf_ = lds + ((S) & 3) * 32768; \
        if (S_ < 9) { const int R_ = min(rs0 + S_, 63); att_issue(bf_, w, KR + (kband + (unsigned)R_ * 8192u), VT + (vband + (unsigned)R_ * 65536u), koff, voff); } \
        else att_issue(bf_, w, KR + (kctx + (unsigned)(S_ - 9) * 8192u), VT + (vctx + (unsigned)(S_ - 9) * 65536u), koff, voff); } while (0)
        bf16x8 qr[4], qn[4];
#pragma unroll
        for (int s = 0; s < 4; ++s) { qn[s] = *(const bf16x8*)(P1 + (size_t)tq * NP1 + h * 128 + 8 * g + 32 * s); qr[s] = lat ? __builtin_nontemporal_load((const bf16x8*)(QR + (size_t)tq * 1024 + h * 128 + 8 * g + 32 * s)) : qn[s]; }
        __builtin_amdgcn_s_barrier();
        ATT_ISSUE(s0); ATT_ISSUE(s0 + 1); ATT_ISSUE(s0 + 2);
        f32x4 o[8];
#pragma unroll
        for (int dt = 0; dt < 8; ++dt) o[dt] = (f32x4){0.f, 0.f, 0.f, 0.f};
        float mrun = -1e30f, lsum = 0.f;
        for (int S = s0; S < nst; ++S) {
            asm volatile("s_waitcnt vmcnt(8)" ::: "memory");
            __builtin_amdgcn_s_barrier();
            asm volatile("" ::: "memory");
            ATT_ISSUE(S + 3);
            const LAS unsigned char* bf = lds + (S & 3) * 32768;
            AttTile t;
            if (S < 9) { const int R = rs0 + S;
                if (R >= rs && R < rs + 8) { att_fetch(t, bf, cb, ql, g, km); att_compute<true>(t, qr, o, mrun, lsum, rp + (R - r + 7) * 31, cb + 8 * g, qc, cs); } }
            else { att_fetch(t, bf, 0, ql, g, km); att_compute<false>(t, qn, o, mrun, lsum, rp, 0, 0, 0);
                   att_fetch(t, bf, 32, ql, g, km); att_compute<false>(t, qn, o, mrun, lsum, rp, 0, 0, 0); }
            asm volatile("s_waitcnt lgkmcnt(0)" ::: "memory");
        }
#undef ATT_ISSUE
        lsum += __shfl_xor(lsum, 16); lsum += __shfl_xor(lsum, 32);
        const float inv = 1.0f / lsum;
        bf16* op = WSP(bf16, O_MIX) + (size_t)tq * D + h * 128 + 4 * g;
#pragma unroll
        for (int dt = 0; dt < 8; ++dt) { u32x2 w2; w2.x = pk2(o[dt][0] * inv, o[dt][1] * inv); w2.y = pk2(o[dt][2] * inv, o[dt][3] * inv); *(u32x2*)(op + dt * 16) = w2; }
        asm volatile("s_waitcnt vmcnt(0)" ::: "memory");
    }
    __syncthreads();
}

__device__ __forceinline__ int chunk_tok0(int b, int ci) { return ci < 4 ? ML + b * 256 + ci * 64 : b * 4096 + (ci - 4) * 64; }
__device__ __forceinline__ void phase_scan1(const Frame& F_) {
    Frame F = F_; F.lane = lane_id_fresh(); asm volatile("" : "+v"(F.lane), "+s"(F.wave)); F.tid = F.wave * 64 + F.lane;
    const int gw = F.bid * NWAVES + F.wave, NGW = F.G * NWAVES;
    for (int task = gw; task < 2176; task += NGW) {
        const int ci = task % 68, cgp = (task / 68) & 7, dir = (task / 544) & 1, b = task / 1088;
        const int c = cgp * 64 + F.lane; const size_t base = ((size_t)dir * MT + chunk_tok0(b, ci)) * 512 + c;
        const unsigned* pa = WSP(const unsigned, O_AA) + base;
        float h = 0.f, Ls = 0.f;
        for (int i0 = 0; i0 < 64; i0 += 16) { unsigned wv[16];
#pragma unroll
            for (int k = 0; k < 16; ++k) { const int ii = dir ? 63 - (i0 + k) : (i0 + k); wv[k] = pa[(size_t)ii * 512]; }
#pragma unroll
            for (int k = 0; k < 16; ++k) { const float la = bf2f(wv[k] & 0xffffu); h = __builtin_amdgcn_exp2f(la * LOG2E) * h + bf2f(wv[k] >> 16); Ls += la; } }
        const size_t so = ((size_t)(b * 2 + dir) * 68 + ci) * 512 + c;
        WSP(float, O_SUMA)[so] = __builtin_amdgcn_exp2f(Ls * LOG2E); WSP(float, O_SUMB)[so] = h;
    }
}
__device__ __forceinline__ float gelu_tanh(float x) { const float t = 0.7978845608028654f * (x + 0.044715f * x * x * x); return 0.5f * x * (1.0f + tanhf(t)); }
__device__ __forceinline__ void phase_scan3(const Frame& F_, int l, LAS unsigned char* lds) {
    Frame F = F_; F.lane = lane_id_fresh(); asm volatile("" : "+v"(F.lane), "+s"(F.wave)); F.tid = F.wave * 64 + F.lane;
    const int gw = F.bid * NWAVES + F.wave, NGW = F.G * NWAVES;
    LAS float* hf = (LAS float*)(lds + F.wave * 16384);
    const float* SA = WSP(const float, O_SUMA); const float* SB = WSP(const float, O_SUMB);
    if (l == 0 && F.G == 256 && F.bid >= 136) convert_items(F, lds, (F.bid - 136) * NWAVES + F.wave, 960, CONV_IA + CONV_IB + CONV_IC1, CONV_PER);
    for (int task = gw; task < 1088; task += NGW) {
        const int ci = task % 68, cgp = (task / 68) & 7, b = task / 544;
        if (l == 1 && ci < 4) continue;
        const int c = cgp * 64 + F.lane; const int tok0 = chunk_tok0(b, ci);
        { float h = 0.f; const size_t sb = ((size_t)(b * 2 + 0) * 68) * 512 + c;
          for (int c0 = 0; c0 < ci; c0 += 8) { float ca[8], cbv[8];
#pragma unroll
              for (int k = 0; k < 8; ++k) { const int cj = min(c0 + k, ci - 1); ca[k] = SA[sb + (size_t)cj * 512]; cbv[k] = SB[sb + (size_t)cj * 512]; }
#pragma unroll
              for (int k = 0; k < 8; ++k) if (c0 + k < ci) h = ca[k] * h + cbv[k]; }
          const unsigned* pa = WSP(const unsigned, O_AA) + ((size_t)tok0) * 512 + c;
          for (int i0 = 0; i0 < 64; i0 += 16) { unsigned wv[16];
#pragma unroll
              for (int k = 0; k < 16; ++k) wv[k] = __builtin_nontemporal_load(&pa[(size_t)(i0 + k) * 512]);
#pragma unroll
              for (int k = 0; k < 16; ++k) { h = __builtin_amdgcn_exp2f(bf2f(wv[k] & 0xffffu) * LOG2E) * h + bf2f(wv[k] >> 16); hf[(i0 + k) * 64 + F.lane] = h; } } }
        { float h = 0.f; const size_t sb = ((size_t)(b * 2 + 1) * 68) * 512 + c;
          const int np = (ci < 4) ? 3 - ci : 4 + (67 - ci);
          for (int p0 = 0; p0 < np; p0 += 8) { float ca[8], cbv[8];
#pragma unroll
              for (int k = 0; k < 8; ++k) { const int p = min(p0 + k, np - 1); const int cj = (p < 4) ? 3 - p : 67 - (p - 4); ca[k] = SA[sb + (size_t)cj * 512]; cbv[k] = SB[sb + (size_t)cj * 512]; }
#pragma unroll
              for (int k = 0; k < 8; ++k) if (p0 + k < np) h = ca[k] * h + cbv[k]; }
          const unsigned* pa = WSP(const unsigned, O_AA) + ((size_t)MT + tok0) * 512 + c;
          const bf16* gp = WSP(const bf16, O_P1) + (size_t)tok0 * NP1 + 2560 + c; bf16* op = WSP(bf16, O_MIX) + (size_t)tok0 * D + 1024 + c;
          for (int i0 = 0; i0 < 64; i0 += 8) { unsigned wv[8]; float gv[8];
#pragma unroll
              for (int k = 0; k < 8; ++k) { const int ii = 63 - (i0 + k); wv[k] = __builtin_nontemporal_load(&pa[(size_t)ii * 512]); gv[k] = bf2f(__builtin_nontemporal_load(&gp[(size_t)ii * NP1])); }
#pragma unroll
              for (int k = 0; k < 8; ++k) { const int ii = 63 - (i0 + k); h = __builtin_amdgcn_exp2f(bf2f(wv[k] & 0xffffu) * LOG2E) * h + bf2f(wv[k] >> 16); const float y = hf[ii * 64 + F.lane] + h;
                  op[(size_t)ii * D] = (bf16)(pk2(y * gelu_tanh(gv[k]), 0.f) & 0xffffu); } } }
    }
    const int gt = F.bid * NTHR + F.tid, NGT = F.G * NTHR;
    const float* fb = F.in[I_FNOB] + (size_t)l * 512; const float* PT = WSP(const float, O_PART);
    for (int it = gt; it < 2 * 2048 * 128; it += NGT) { const int n4 = it & 127, k = (it >> 7) & 2047, b = it >> 18;
        const bf16* p = (const bf16*)PT + ((size_t)b * 2048 + k) * 512 + n4 * 4;
        f32x4 c = (f32x4){0.f, 0.f, 0.f, 0.f}, sn = c;
#pragma unroll
        for (int ks = 0; ks < 4; ++ks) { const u32x2 wc_ = __builtin_nontemporal_load((const u32x2*)(p + (size_t)ks * 4096 * 512)), ws_ = __builtin_nontemporal_load((const u32x2*)(p + (size_t)(4 + ks) * 4096 * 512));
            c[0] += bf2f(wc_.x & 0xffffu); c[1] += bf2f(wc_.x >> 16); c[2] += bf2f(wc_.y & 0xffffu); c[3] += bf2f(wc_.y >> 16);
            sn[0] += bf2f(ws_.x & 0xffffu); sn[1] += bf2f(ws_.x >> 16); sn[2] += bf2f(ws_.y & 0xffffu); sn[3] += bf2f(ws_.y >> 16); }
        const f32x4 bv = *(const f32x4*)(fb + n4 * 4);
        const f32x4 y1 = c + sn + bv, y2 = c - sn + bv;
        u32x2 w; w.x = pk2(y1[0], y1[1]); w.y = pk2(y1[2], y1[3]);
        *(u32x2*)(WSP(bf16, O_MIX) + ((size_t)b * 4096 + k) * D + 1536 + n4 * 4) = w;
        if (k > 0) { w.x = pk2(y2[0], y2[1]); w.y = pk2(y2[2], y2[3]); *(u32x2*)(WSP(bf16, O_MIX) + ((size_t)b * 4096 + 4096 - k) * D + 1536 + n4 * 4) = w; } }
    for (int task = gw; task < 1024; task += NGW) { const int n = task & 511, b = task >> 9;
        const bf16* ap = WSP(const bf16, O_ABT) + ((size_t)(b * 512 + n) * 2) * 4096 + F.lane * 64; float sacc = 0.f;
#pragma unroll
        for (int j = 0; j < 8; ++j) { const u32x4 v = *(const u32x4*)(ap + j * 8); const unsigned vw[4] = {v.x, v.y, v.z, v.w};
#pragma unroll
            for (int q = 0; q < 4; ++q) sacc += bf2f(vw[q] & 0xffffu) - bf2f(vw[q] >> 16); }
        sacc = wave_sum(sacc);
        if (F.lane == 0) WSP(bf16, O_MIX)[((size_t)b * 4096 + 2048) * D + 1536 + n] = (bf16)(pk2(sacc * 0.00138106793f + fb[n], 0.f) & 0xffffu); }
    if (l == 0) for (int it = gt; it < 512 * 128; it += NGT) { const int n4 = it & 127, r = it >> 7;
        const f32x4 v = *(const f32x4*)(PT + 16777216 + (size_t)r * 512 + n4 * 4) + *(const f32x4*)(fb + n4 * 4);
        u32x2 w; w.x = pk2(v[0], v[1]); w.y = pk2(v[2], v[3]);
        *(u32x2*)(WSP(bf16, O_MIX) + (size_t)(ML + r) * D + 1536 + n4 * 4) = w; }
}

__global__ void __launch_bounds__(NTHR, 2) mega_fwd(Params p) {
    extern __shared__ __attribute__((aligned(16))) unsigned char lds_raw[];
    LAS unsigned char* lds = (LAS unsigned char*)lds_raw;
    cg::grid_group grid = cg::this_grid();
    Frame F; F.in = p.in; F.ws = p.ws; F.out = p.out; F.tid = 0; F.lane = 0; F.wave = __builtin_amdgcn_readfirstlane(threadIdx.x >> 6); F.G = gridDim.x; F.bid = blockIdx.x;
#define modv WSP(const float, O_MODV)
    volatile LAS unsigned* xst = (volatile LAS unsigned*)(lds + 131072 + 64);
    if (threadIdx.x < 2) xst[threadIdx.x] = 0u;
    __syncthreads();
    (void)xcd_barrier_post(WSP(unsigned, O_BAR), xst);

#ifndef SK_PRO
    for (int _r = 0; _r < REP_PRO; ++_r) { phase_prologue(F, lds); __syncthreads(); }
#endif
    if (gridDim.y == 0x7fffffffu) grid.sync();
    GSYNC();
    phase_ln(F, 0, 0, MT, nullptr, nullptr, nullptr, true, modv, 0, 2048);
    __syncthreads();
#ifndef SK_FOLD
    { Sched S; S.init(F.ws, M_FOLD, 0, F.G, F.bid); EpiB E{F.ws, F.in, M_FOLD, 0}; pg8::gemm_phase<EpiB, Sched>(lds, F.wave, 512, 512, 8, S, E); }
#endif
    GSYNC();

    for (int l = 0; l < 2; ++l) {
#ifndef SK_INPROJ
        for (int _r = 0; _r < REP_INPROJ; ++_r) { __syncthreads(); Sched S; S.init(F.ws, M_INPROJ, l, F.G, F.bid); EpiB E{F.ws, F.in, M_INPROJ, l}; pg8::gemm_phase<EpiB, Sched>(lds, F.wave, 2048, 2048, 32, S, E); }
        if (l == 0 && F.G == 256 && F.bid >= 168) { Frame Fc = F; Fc.lane = lane_id_fresh(); asm volatile("" : "+v"(Fc.lane)); convert_items(Fc, lds, (F.bid - 168) * NWAVES + F.wave, 704, CONV_IA, CONV_IA + CONV_IB + CONV_IC1); }
#endif
        GSYNC();
#ifndef SK_ROPE
        for (int _r = 0; _r < REP_ELT; ++_r) { phase_rope_conv(F, l, lds); __syncthreads(); }
#endif
        GSYNC();
#ifndef SK_DFT
        for (int _r = 0; _r < REP_DFTG; ++_r) { __syncthreads(); Sched S; S.init(F.ws, M_DFT, l, F.G, F.bid); EpiF E{F.ws, F.in, M_DFT, l}; pg8::gemm_phase<EpiF, Sched>(lds, F.wave, 8192, 8192, 16, S, E); }
#endif
        __syncthreads();
#ifndef SK_GATES
        for (int _r = 0; _r < REP_DFTG; ++_r) { __syncthreads(); Sched S; S.init(F.ws, M_GATES, l, F.G, F.bid); EpiF E{F.ws, F.in, M_GATES, l}; pg8::gemm_phase<EpiF, Sched>(lds, F.wave, 512, 512, 2, S, E); }
        if (l == 0) { __syncthreads(); Sched S; S.init(F.ws, M_CDFT, l, F.G, F.bid); EpiF E{F.ws, F.in, M_CDFT, l}; pg8::gemm_phase<EpiF, Sched>(lds, F.wave, 512, 512, 8, S, E); }
#endif
#ifndef SK_ATT
        for (int _r = 0; _r < REP_ATT; ++_r) phase_attention(F, l, lds);
#endif
        GSYNC();
#ifndef SK_SCAN
        for (int _r = 0; _r < REP_ELT; ++_r) phase_scan1(F);
#endif
        GSYNC();
#ifndef SK_SCAN
        for (int _r = 0; _r < REP_ELT; ++_r) { phase_scan3(F, l, lds); __syncthreads(); }
#endif
        GSYNC();
#ifndef SK_WOUT
        for (int _r = 0; _r < REP_WOUT; ++_r) { __syncthreads(); Sched S; S.init(F.ws, M_WOUT, l, F.G, F.bid); EpiLN E{F.ws, F.in, F.out, M_WOUT, l, _r < REP_WOUT - 1}; pg8::gemm_phase<EpiLN, Sched>(lds, F.wave, 2048, 2048, 32, S, E); }
        if (l == 0) { __syncthreads(); Sched S; S.init(F.ws, M_WOUTC, l, F.G, F.bid); EpiF E{F.ws, F.in, M_WOUTC, l}; pg8::gemm_phase<EpiF, Sched>(lds, F.wave, 2048, 2048, 8, S, E); }
#endif
        GSYNC();
        if (l == 0) {
            for (int _r = 0; _r < REP_ELT; ++_r) phase_ln(F, 1, ML, MT, F.in[I_LN1G], F.in[I_LN1B], WSP(float, O_X), true, modv, 6144, 8192, 4, F.in[I_CTX], modv + 2 * 12288 + 4096, nullptr);
            GSYNC();
        }
#ifndef SK_FC1
        for (int _r = 0; _r < REP_FC1; ++_r) { __syncthreads(); Sched S; S.init(F.ws, M_FC1, l, F.G, F.bid); EpiB E{F.ws, F.in, M_FC1, l}; pg8::gemm_phase<EpiB, Sched>(lds, F.wave, 2048, 2048, 32, S, E); }
        if (l == 0 && F.G == 256 && F.bid >= 64) { Frame Fc = F; Fc.lane = lane_id_fresh(); asm volatile("" : "+v"(Fc.lane)); convert_items(Fc, lds, (F.bid - 64) * NWAVES + F.wave, 1536, CONV_PER, 2 * CONV_PER); }
#endif
        GSYNC();
#ifndef SK_FC2
        for (int _r = 0; _r < REP_FC2; ++_r) { __syncthreads(); Sched S; S.init(F.ws, M_FC2, l, F.G, F.bid); EpiLN E{F.ws, F.in, F.out, M_FC2, l, _r < REP_FC2 - 1}; pg8::gemm_phase<EpiLN, Sched>(lds, F.wave, 8192, 8192, 128, S, E); }
        if (l == 0) { __syncthreads(); Sched S; S.init(F.ws, M_FC2C, l, F.G, F.bid); EpiF E{F.ws, F.in, M_FC2C, l}; pg8::gemm_phase<EpiF, Sched>(lds, F.wave, 8192, 8192, 16, S, E); }
#endif
        if (l == 0) {
            GSYNC();
            phase_ln(F, 1, ML, MT, F.in[I_LN2G], F.in[I_LN2B], WSP(float, O_X), true, modv + (size_t)3 * 12288, 0, 2048, 8, WSP(const float, O_X) + (size_t)ML * D, modv + 2 * 12288 + 10240, F.in[I_BFC2]);
            GSYNC();
        }
    }
}

extern "C" void kernel_launch(void* const* d_in, const int* in_sizes, int n_in, void* d_out, int out_size, void* d_ws, size_t ws_size, hipStream_t stream) {
    static int grid = 0;
    if (grid == 0) {
        if (n_in != 26 || ws_size < O_END) { fprintf(stderr, "kernel_launch: unexpected n_in %d / ws %zu (need %zu)\n", n_in, ws_size, (size_t)O_END); grid = -1; return; }
        int dev = 0, cus = 0, per_cu = 0;
        hipGetDevice(&dev); hipDeviceGetAttribute(&cus, hipDeviceAttributeMultiprocessorCount, dev);
        hipFuncSetAttribute((const void*)mega_fwd, hipFuncAttributeMaxDynamicSharedMemorySize, LDS_BYTES);
        hipOccupancyMaxActiveBlocksPerMultiprocessor(&per_cu, (const void*)mega_fwd, NTHR, LDS_BYTES);
        if (per_cu < 1) { fprintf(stderr, "kernel_launch: occupancy query says %d blocks per CU\n", per_cu); per_cu = 1; }
        grid = cus;
        (void)hipGetLastError();
    }
    if (grid < 0) return;
    Params p{};
    for (int i = 0; i < 26; ++i) p.in[i] = (const float*)d_in[i];
    p.out = (float*)d_out; p.ws = (unsigned char*)d_ws;
    if (hipMemsetAsync((char*)d_ws + O_BAR, 0, MEMSET_BYTES, stream) != hipSuccess) { fprintf(stderr, "kernel_launch: memset failed\n"); return; }
    void* args[] = {&p};
    hipError_t e = hipLaunchCooperativeKernel((const void*)mega_fwd, dim3(grid), dim3(NTHR), args, LDS_BYTES, stream);
    if (e != hipSuccess) fprintf(stderr, "cooperative launch failed: %s (grid %d)\n", hipGetErrorString(e), grid);
}
```
